# Optimizing an MI355X kernel written in HIP

```python
import math
import jax, jax.numpy as jnp
from jax import lax
import numpy as np

D_MODEL = 1024
BATCH = 8
SEQ = 2048
DEPTH = 4

N_A_LAYERS = DEPTH // 2
N_B_LAYERS = DEPTH - N_A_LAYERS
S5_GROUP = 16
S5_GROUPS = D_MODEL // S5_GROUP
S5_STATE = 64
N_HEADS = 16
HEAD_DIM = D_MODEL // N_HEADS
MOBA_BLOCK = 256
MOBA_TOPK = 3
Q_CHUNK = 32
D_FF = 256 * ((8 * D_MODEL // 3 + 255) // 256)
EPS = 1e-6
NEG = -1e30

kernel_name = 'hybrid_s5_moba_macaron_yoco'


def rmsnorm(x, g):
    xf = x.astype(jnp.float32)
    xf = xf * lax.rsqrt(jnp.mean(xf * xf, axis=-1, keepdims=True) + EPS)
    return (xf * g.astype(jnp.float32)).astype(x.dtype)


def swiglu(x, w_in, w_out):
    g, u = jnp.split(x @ w_in, 2, axis=-1)
    return (jax.nn.silu(g) * u) @ w_out


def alibi_slopes():
    return jnp.exp2(-8.0 * jnp.arange(1, N_HEADS + 1, dtype=jnp.float32) / N_HEADS)


def s5_mixer(u, a_re, a_im, b_re, b_im, c_re, c_im, d_skip, log_step, w_glu):
    f32 = jnp.float32
    bsz, seq_len, _ = u.shape
    uf = u.astype(f32)
    ug = uf.reshape(bsz, seq_len, S5_GROUPS, S5_GROUP)
    dt = jnp.exp(log_step.astype(f32))[:, None]
    ar = jnp.minimum(a_re.astype(f32), -1e-4)
    ai = a_im.astype(f32)
    mag = jnp.exp(ar * dt)
    lr = mag * jnp.cos(ai * dt)
    li = mag * jnp.sin(ai * dt)
    nr = lr - 1.0
    den = ar * ar + ai * ai
    fr = (nr * ar + li * ai) / den
    fi = (li * ar - nr * ai) / den
    br = b_re.astype(f32)
    bi = b_im.astype(f32)
    bbr = fr[..., None] * br - fi[..., None] * bi
    bbi = fr[..., None] * bi + fi[..., None] * br
    bu_re = jnp.einsum('blgj,gpj->blgp', ug, bbr)
    bu_im = jnp.einsum('blgj,gpj->blgp', ug, bbi)
    a_r = jnp.broadcast_to(lr, (1, seq_len, S5_GROUPS, S5_STATE))
    a_i = jnp.broadcast_to(li, (1, seq_len, S5_GROUPS, S5_STATE))

    def combine(e1, e2):
        a1r, a1i, b1r, b1i = e1
        a2r, a2i, b2r, b2i = e2
        return (a2r * a1r - a2i * a1i,
                a2r * a1i + a2i * a1r,
                a2r * b1r - a2i * b1i + b2r,
                a2r * b1i + a2i * b1r + b2i)

    _, _, xr, xi = lax.associative_scan(combine, (a_r, a_i, bu_re, bu_im), axis=1)
    y = (jnp.einsum('blgp,gjp->blgj', xr, c_re.astype(f32))
         - jnp.einsum('blgp,gjp->blgj', xi, c_im.astype(f32)))
    y = y.reshape(bsz, seq_len, D_MODEL) + d_skip.astype(f32) * uf
    z = jax.nn.gelu(y).astype(u.dtype)
    za, zb = jnp.split(z @ w_glu, 2, axis=-1)
    return za * jax.nn.sigmoid(zb)


def shared_kv(h, kv_norm, w_kv):
    bsz, seq_len, _ = h.shape
    lp = -(-seq_len // MOBA_BLOCK) * MOBA_BLOCK
    nb = lp // MOBA_BLOCK
    kv = rmsnorm(h, kv_norm) @ w_kv
    kv = jnp.pad(kv, ((0, 0), (0, lp - seq_len), (0, 0)))
    k, v = jnp.split(kv, 2, axis=-1)

    def to_blocks(a):
        return a.reshape(bsz, nb, MOBA_BLOCK, N_HEADS, HEAD_DIM).transpose(0, 3, 1, 2, 4)

    kb = to_blocks(k)
    vb = to_blocks(v)
    kmean = jnp.mean(kb.astype(jnp.float32), axis=3).astype(kb.dtype)
    return kb, vb, kmean


def moba_attention(xn, w_q, w_o, kb, vb, kmean):
    bsz, seq_len, _ = xn.shape
    nb = kb.shape[2]
    lp = nb * MOBA_BLOCK
    n_chunks = lp // Q_CHUNK
    k_sel = min(MOBA_TOPK, nb)
    q = jnp.pad(xn @ w_q, ((0, 0), (0, lp - seq_len), (0, 0)))
    q = q.reshape(bsz, n_chunks, Q_CHUNK, N_HEADS, HEAD_DIM).transpose(1, 0, 2, 3, 4)
    starts = jnp.arange(n_chunks, dtype=jnp.int32) * Q_CHUNK
    slopes = alibi_slopes()
    scale = HEAD_DIM ** -0.5
    b_ix = jnp.arange(bsz)[:, None, None, None]
    h_ix = jnp.arange(N_HEADS)[None, None, :, None]
    offs = jnp.arange(MOBA_BLOCK, dtype=jnp.int32)

    def attend(args):
        qc, start = args
        t = start + jnp.arange(Q_CHUNK, dtype=jnp.int32)
        own = start // MOBA_BLOCK
        gate = jnp.einsum('bqhd,bhnd->bqhn', qc, kmean).astype(jnp.float32)
        gate = jnp.where(jnp.arange(nb) < own, gate, NEG)
        _, idx = lax.top_k(gate, k_sel)
        valid = jnp.arange(k_sel) < own
        kg = kb[b_ix, h_ix, idx]
        vg = vb[b_ix, h_ix, idx]
        s_sel = jnp.einsum('bqhd,bqhrkd->bqhrk', qc, kg).astype(jnp.float32) * scale
        kpos = idx[..., None] * MOBA_BLOCK + offs
        dist = (t[None, :, None, None, None] - kpos).astype(jnp.float32)
        s_sel = s_sel - slopes[None, None, :, None, None] * dist
        s_sel = jnp.where(valid[:, None], s_sel, NEG)
        k_own = lax.dynamic_index_in_dim(kb, own, axis=2, keepdims=False)
        v_own = lax.dynamic_index_in_dim(vb, own, axis=2, keepdims=False)
        s_own = jnp.einsum('bqhd,bhkd->bqhk', qc, k_own).astype(jnp.float32) * scale
        dist_own = (t[:, None] - (own * MOBA_BLOCK + offs)[None, :]).astype(jnp.float32)
        s_own = s_own - slopes[None, None, :, None] * dist_own[None, :, None, :]
        s_own = jnp.where(dist_own[None, :, None, :] >= 0, s_own, NEG)
        logits = jnp.concatenate(
            [s_sel.reshape(bsz, Q_CHUNK, N_HEADS, k_sel * MOBA_BLOCK), s_own], axis=-1)
        p = jax.nn.softmax(logits, axis=-1).astype(vb.dtype)
        p_sel = p[..., :k_sel * MOBA_BLOCK].reshape(bsz, Q_CHUNK, N_HEADS, k_sel, MOBA_BLOCK)
        p_own = p[..., k_sel * MOBA_BLOCK:]
        return (jnp.einsum('bqhrk,bqhrkd->bqhd', p_sel, vg)
                + jnp.einsum('bqhk,bhkd->bqhd', p_own, v_own))

    o = lax.map(attend, (q, starts))
    o = o.transpose(1, 0, 2, 3, 4).reshape(bsz, lp, D_MODEL)[:, :seq_len]
    return o @ w_o


def setup_inputs(seed: int = 0) -> dict:
    key = jax.random.key(seed)
    ks = jax.random.split(key, 22)
    f32 = jnp.float32
    n_a, n_b = N_A_LAYERS, N_B_LAYERS
    G, P, GC = S5_GROUPS, S5_STATE, S5_GROUP

    def nrm(k, shape, scale):
        return jax.random.normal(k, shape, f32) * scale

    def gain(k, shape):
        return 1.0 + 0.02 * jax.random.normal(k, shape, f32)

    n_idx = jnp.arange(P, dtype=f32)
    return {
        'x': jax.random.normal(ks[0], (BATCH, SEQ, D_MODEL), f32),
        'ffn1_norm': gain(ks[1], (DEPTH, D_MODEL)),
        'ffn1_w_in': nrm(ks[2], (DEPTH, D_MODEL, 2 * D_FF), D_MODEL ** -0.5),
        'ffn1_w_out': nrm(ks[3], (DEPTH, D_FF, D_MODEL), D_FF ** -0.5),
        'mix_norm': gain(ks[4], (DEPTH, D_MODEL)),
        'ffn2_norm': gain(ks[5], (DEPTH, D_MODEL)),
        'ffn2_w_in': nrm(ks[6], (DEPTH, D_MODEL, 2 * D_FF), D_MODEL ** -0.5),
        'ffn2_w_out': nrm(ks[7], (DEPTH, D_FF, D_MODEL), D_FF ** -0.5),
        's5_a_re': -0.5 + 0.01 * jax.random.normal(ks[8], (n_a, G, P), f32),
        's5_a_im': math.pi * n_idx + 0.01 * jax.random.normal(ks[9], (n_a, G, P), f32),
        's5_b_re': nrm(ks[10], (n_a, G, P, GC), (2 * GC) ** -0.5),
        's5_b_im': nrm(ks[11], (n_a, G, P, GC), (2 * GC) ** -0.5),
        's5_c_re': nrm(ks[12], (n_a, G, GC, P), P ** -0.5),
        's5_c_im': nrm(ks[13], (n_a, G, GC, P), P ** -0.5),
        's5_d': nrm(ks[14], (n_a, D_MODEL), 1.0),
        's5_log_step': jax.random.uniform(ks[15], (n_a, G), f32, math.log(1e-3), math.log(1e-1)),
        's5_w_glu': nrm(ks[16], (n_a, D_MODEL, 2 * D_MODEL), D_MODEL ** -0.5),
        'kv_norm': gain(ks[17], (D_MODEL,)),
        'w_kv': nrm(ks[18], (D_MODEL, 2 * D_MODEL), D_MODEL ** -0.5),
        'w_q': nrm(ks[19], (n_b, D_MODEL, D_MODEL), D_MODEL ** -0.5),
        'w_o': nrm(ks[20], (n_b, D_MODEL, D_MODEL), D_MODEL ** -0.5),
        'final_norm': gain(ks[21], (D_MODEL,)),
    }


def reference(x, ffn1_norm, ffn1_w_in, ffn1_w_out, mix_norm, ffn2_norm, ffn2_w_in, ffn2_w_out,
              s5_a_re, s5_a_im, s5_b_re, s5_b_im, s5_c_re, s5_c_im, s5_d, s5_log_step, s5_w_glu,
              kv_norm, w_kv, w_q, w_o, final_norm):
    h = x
    kb = vb = kmean = None
    for layer in range(DEPTH):
        if layer == N_A_LAYERS:
            kb, vb, kmean = shared_kv(h, kv_norm, w_kv)
        h = h + 0.5 * swiglu(rmsnorm(h, ffn1_norm[layer]), ffn1_w_in[layer], ffn1_w_out[layer])
        hn = rmsnorm(h, mix_norm[layer])
        if layer < N_A_LAYERS:
            h = h + s5_mixer(hn, s5_a_re[layer], s5_a_im[layer], s5_b_re[layer], s5_b_im[layer],
                             s5_c_re[layer], s5_c_im[layer], s5_d[layer], s5_log_step[layer],
                             s5_w_glu[layer])
        else:
            j = layer - N_A_LAYERS
            h = h + moba_attention(hn, w_q[j], w_o[j], kb, vb, kmean)
        h = h + 0.5 * swiglu(rmsnorm(h, ffn2_norm[layer]), ffn2_w_in[layer], ffn2_w_out[layer])
    return rmsnorm(h, final_norm)
```

```cpp
#include <hip/hip_runtime.h>
#include <cstdio>
#include <cstdint>
namespace pg8 {
#define PG8_LAS __attribute__((address_space(3)))
typedef unsigned short bf16_t;
typedef short bf16x8 __attribute__((ext_vector_type(8)));
typedef float f32x4 __attribute__((ext_vector_type(4)));
typedef unsigned u32x4 __attribute__((ext_vector_type(4)));
constexpr int BM = 256, BK = 64, HALF = 128, HTB = HALF * BK * 2  , STAGE_BYTES = 8 * HTB, NXCD = 8, WGM = 8;

__host__ __device__ __forceinline__ int lds_byte(int r, int c) { const int st = (r >> 4) * 2 + (c >> 5), rr = r & 15, cc = c & 31, ob = rr * 64 + cc * 2; return st * 1024 + (ob ^ (((ob >> 9) & 1) << 5)); }
__host__ __device__ __forceinline__ void stage_rc(int b, int& R, int& C) { const int st = b / 1024, sb = b % 1024, swz = sb ^ (((sb >> 9) & 1) << 5); R = (st >> 1) * 16 + swz / 64; C = (st & 1) * 32 + (swz % 64) / 2; }
__host__ __device__ __forceinline__ int perm32(int rho) { const int n = rho >> 4, i = rho & 15; return 8 * (i >> 2) + 4 * n + (i & 3); }

struct Unit { int pm, pn; };
struct Gemm { const bf16_t* A; const bf16_t* Bt; int M, N, K; };

struct StaticOrder {
    int nM, nN, nwg, G, c;
    __host__ __device__ void init(int M, int N, int G_, int c_) { nM = M / BM; nN = N / BM; nwg = nM * nN; G = G_; c = c_; }
    __host__ __device__ bool next(int i, Unit& u) const {
        const long L = (long)i * G + c; if (L >= nwg) return false;
        int wgid = (int)L; { const int q = nwg / NXCD, r = nwg % NXCD, xcd = wgid % NXCD, off = wgid / NXCD; wgid = (xcd < r ? xcd * (q + 1) : r * (q + 1) + (xcd - r) * q) + off; }
        const int nig = WGM * nN, gid = wgid / nig, fm = gid * WGM, gsz = (nM - fm) < WGM ? (nM - fm) : WGM;
        u.pm = fm + ((wgid % nig) % gsz); u.pn = (wgid % nig) / gsz; return true;
    }
    __device__ __forceinline__ void a_ready(const Unit&) const {}
    __device__ __forceinline__ void done(const Unit&) const {}
};

__device__ __forceinline__ unsigned cvt_pk_bf16(float lo, float hi) { unsigned r; asm volatile("v_cvt_pk_bf16_f32 %0, %1, %2" : "=v"(r) : "v"(lo), "v"(hi)); return r; }
typedef float f32x2 __attribute__((ext_vector_type(2)));
constexpr float RMS_EPS = 1e-6f;
typedef unsigned long long stat_t;
__device__ __forceinline__ float rstd_of(const stat_t* st, int row) { return rsqrtf((float)st[row] * (1.0f / (4294967296.0f * 1024.0f)) + RMS_EPS); }
__device__ __forceinline__ void stat_add(stat_t* st, int row, float ss) { atomicAdd(st + row, (stat_t)(ss * 4294967296.0f)); }
__device__ __forceinline__ float fast_sigmoid(float x) { return __builtin_amdgcn_rcpf(1.0f + __builtin_amdgcn_exp2f(-1.4426950408889634f * x)); }
typedef unsigned u32x4e __attribute__((ext_vector_type(4)));

struct EpiSwiGLU {
    static constexpr bool PERM = true, AFTER_DRAIN = false;
    bf16_t* O; int ldc; const stat_t* st;
    __device__ __forceinline__ void operator()(const f32x4 (&acc)[2][2][4][2], const Unit& u, int wr, int wc, int fr, int fq) const {
        const int row0 = u.pm * BM + wr * 64 + fr, col0 = u.pn * HALF + wc * 32 + 8 * fq;
#pragma unroll
        for (int ai = 0; ai < 2; ++ai)
#pragma unroll
            for (int m = 0; m < 4; ++m) {
                const int row = row0 + ai * HALF + m * 16; const float r = rstd_of(st, row);
                float o[8];
#pragma unroll
                for (int n = 0; n < 2; ++n)
#pragma unroll
                    for (int e = 0; e < 4; ++e) { const float g = acc[ai][0][m][n][e] * r, uu = acc[ai][1][m][n][e] * r; o[n * 4 + e] = g * fast_sigmoid(g) * uu; }
                u32x4e w; w.x = cvt_pk_bf16(o[0], o[1]); w.y = cvt_pk_bf16(o[2], o[3]); w.z = cvt_pk_bf16(o[4], o[5]); w.w = cvt_pk_bf16(o[6], o[7]);
                *(u32x4e*)(O + (size_t)row * ldc + col0) = w; }
    }
};
struct EpiRes {
    static constexpr bool PERM = true, AFTER_DRAIN = false;
    const float* base; float* out; bf16_t* hb; stat_t* sto; float scale;
    __device__ __forceinline__ void operator()(const f32x4 (&acc)[2][2][4][2], const Unit& u, int wr, int wc, int fr, int fq) const {
        const int row0 = u.pm * BM + wr * 64 + fr, col0 = u.pn * BM + wc * 32 + 8 * fq;
#pragma unroll
        for (int ai = 0; ai < 2; ++ai)
#pragma unroll
            for (int m = 0; m < 4; ++m) {
                const int row = row0 + ai * HALF + m * 16; float ss = 0.f;
#pragma unroll
                for (int bj = 0; bj < 2; ++bj) {
                    const size_t off = (size_t)row * 1024 + col0 + bj * HALF;
                    const f32x4 b0 = *(const f32x4*)(base + off), b1 = *(const f32x4*)(base + off + 4);
                    const f32x4 v0 = b0 + acc[ai][bj][m][0] * scale, v1 = b1 + acc[ai][bj][m][1] * scale;
                    *(f32x4*)(out + off) = v0; *(f32x4*)(out + off + 4) = v1;
                    u32x4e w; w.x = cvt_pk_bf16(v0[0], v0[1]); w.y = cvt_pk_bf16(v0[2], v0[3]); w.z = cvt_pk_bf16(v1[0], v1[1]); w.w = cvt_pk_bf16(v1[2], v1[3]);
                    *(u32x4e*)(hb + off) = w;
                    ss += (v0[0] * v0[0] + v0[1] * v0[1]) + (v0[2] * v0[2] + v0[3] * v0[3]) + (v1[0] * v1[0] + v1[1] * v1[1]) + (v1[2] * v1[2] + v1[3] * v1[3]); }
                ss += __shfl_xor(ss, 16); ss += __shfl_xor(ss, 32);
                if (fq == 0) stat_add(sto, row, ss); }
    }
};
struct EpiGluRes {
    static constexpr bool PERM = true, AFTER_DRAIN = false;
    const float* base; float* out; bf16_t* hb; stat_t* sto;
    __device__ __forceinline__ void operator()(const f32x4 (&acc)[2][2][4][2], const Unit& u, int wr, int wc, int fr, int fq) const {
        const int row0 = u.pm * BM + wr * 64 + fr, col0 = u.pn * HALF + wc * 32 + 8 * fq;
#pragma unroll
        for (int ai = 0; ai < 2; ++ai)
#pragma unroll
            for (int m = 0; m < 4; ++m) {
                const int row = row0 + ai * HALF + m * 16; const size_t off = (size_t)row * 1024 + col0;
                const f32x4 b0 = *(const f32x4*)(base + off), b1 = *(const f32x4*)(base + off + 4);
                f32x4 v0, v1;
#pragma unroll
                for (int e = 0; e < 4; ++e) { v0[e] = b0[e] + acc[ai][0][m][0][e] * fast_sigmoid(acc[ai][1][m][0][e]); v1[e] = b1[e] + acc[ai][0][m][1][e] * fast_sigmoid(acc[ai][1][m][1][e]); }
                *(f32x4*)(out + off) = v0; *(f32x4*)(out + off + 4) = v1;
                u32x4e w; w.x = cvt_pk_bf16(v0[0], v0[1]); w.y = cvt_pk_bf16(v0[2], v0[3]); w.z = cvt_pk_bf16(v1[0], v1[1]); w.w = cvt_pk_bf16(v1[2], v1[3]);
                *(u32x4e*)(hb + off) = w;
                float ss = (v0[0] * v0[0] + v0[1] * v0[1]) + (v0[2] * v0[2] + v0[3] * v0[3]) + (v1[0] * v1[0] + v1[1] * v1[1]) + (v1[2] * v1[2] + v1[3] * v1[3]);
                ss += __shfl_xor(ss, 16); ss += __shfl_xor(ss, 32);
                if (fq == 0) stat_add(sto, row, ss); }
    }
};
template <bool KMEAN> struct EpiRowScale {
    static constexpr bool PERM = true, AFTER_DRAIN = false;
    bf16_t* O0; bf16_t* O1; const stat_t* st; float mul; float* kmp;
    __device__ __forceinline__ void operator()(const f32x4 (&acc)[2][2][4][2], const Unit& u, int wr, int wc, int fr, int fq) const {
        const int row0 = u.pm * BM + wr * 64 + fr, t = u.pn >> 2, col0 = (u.pn & 3) * BM + wc * 32 + 8 * fq;
        bf16_t* O = t ? O1 : O0;
        float cs[2][8];
#pragma unroll
        for (int bj = 0; bj < 2; ++bj)
#pragma unroll
            for (int j = 0; j < 8; ++j) cs[bj][j] = 0.f;
#pragma unroll
        for (int ai = 0; ai < 2; ++ai)
#pragma unroll
            for (int m = 0; m < 4; ++m) {
                const int row = row0 + ai * HALF + m * 16; const float r = rstd_of(st, row) * mul;
#pragma unroll
                for (int bj = 0; bj < 2; ++bj) {
                    const f32x4 v0 = acc[ai][bj][m][0] * r, v1 = acc[ai][bj][m][1] * r;
                    u32x4e w; w.x = cvt_pk_bf16(v0[0], v0[1]); w.y = cvt_pk_bf16(v0[2], v0[3]); w.z = cvt_pk_bf16(v1[0], v1[1]); w.w = cvt_pk_bf16(v1[2], v1[3]);
                    *(u32x4e*)(O + (size_t)row * 1024 + col0 + bj * HALF) = w;
                    if (KMEAN) {
#pragma unroll
                        for (int e = 0; e < 4; ++e) { cs[bj][e] += v0[e]; cs[bj][4 + e] += v1[e]; } } } }
        if (KMEAN) {
            if (t == 0) {
#pragma unroll
                for (int bj = 0; bj < 2; ++bj)
#pragma unroll
                    for (int j = 0; j < 8; ++j) { float s = cs[bj][j]; s += __shfl_xor(s, 1); s += __shfl_xor(s, 2); s += __shfl_xor(s, 4); s += __shfl_xor(s, 8); cs[bj][j] = s; }
                if (fr == 0) {
#pragma unroll
                    for (int bj = 0; bj < 2; ++bj) { float* p = kmp + ((size_t)wr * 64 + u.pm) * 1024 + col0 + bj * HALF;
                        *(f32x4*)p = (f32x4){cs[bj][0], cs[bj][1], cs[bj][2], cs[bj][3]}; *(f32x4*)(p + 4) = (f32x4){cs[bj][4], cs[bj][5], cs[bj][6], cs[bj][7]}; } } } }
    }
};
template <class Epi, class Sched, bool ALIGN_EPI = false, bool SP2 = false>
__device__ __forceinline__ void gemm_phase(PG8_LAS unsigned char* lds, const Gemm g, const Sched& S, const Epi& E) {
    int tid_o = threadIdx.x; asm volatile("" : "+v"(tid_o));
    const int tid = tid_o, wid = __builtin_amdgcn_readfirstlane(tid >> 6), lane = tid & 63, wr = wid >> 2, wc = wid & 3, fr = lane & 15, fq = lane >> 4;
    const int K = g.K, nt = K / BK;
    unsigned voffA[2], voffB[2];
#pragma unroll
    for (int i = 0; i < 2; ++i) { int R, C; stage_rc(tid * 16 + i * 8192, R, C); const int Rb = Epi::PERM ? ((R & ~31) + perm32(R & 31)) : R;
        voffA[i] = (unsigned)(R * K + C) * 2u; voffB[i] = (unsigned)(Rb * K + C) * 2u; }
    const size_t kstep = (size_t)(BK * 2);
    const size_t hstep = (size_t)HALF * K * 2;
    const size_t tstep = 2 * hstep;
    const unsigned ldsw = (unsigned)wid * 1024u;
    const int aoff = lds_byte(wr * 64 + fr, fq * 8), boff = lds_byte(wc * 32 + fr, fq * 8);
#define PG8_SA(b, h) (((b) * 2 + (h)) * HTB)
#define PG8_SB(b, h) ((4 + (b) * 2 + (h)) * HTB)
#define PG8_STAGE(bufoff, gbase, voff) do { _Pragma("unroll") for (int _i = 0; _i < 2; ++_i) \
        __builtin_amdgcn_global_load_lds((const unsigned*)((const char*)(gbase) + (voff)[_i]), (PG8_LAS unsigned*)(lds + (bufoff) + ldsw + _i * 8192), 16, 0, 0); } while (0)
#define PG8_LDA(dst, b, h) do { _Pragma("unroll") for (int m = 0; m < 4; ++m) _Pragma("unroll") for (int k = 0; k < 2; ++k) dst[m][k] = *(const PG8_LAS bf16x8*)(lds + PG8_SA(b, h) + aoff + m * 2048 + k * 1024); } while (0)
#define PG8_LDB(dst, b, h) do { _Pragma("unroll") for (int n = 0; n < 2; ++n) _Pragma("unroll") for (int k = 0; k < 2; ++k) dst[n][k] = *(const PG8_LAS bf16x8*)(lds + PG8_SB(b, h) + boff + n * 2048 + k * 1024); } while (0)
#define PG8_MMA(ai, bj, At, Bt) do { __builtin_amdgcn_s_setprio(1); _Pragma("unroll") for (int m = 0; m < 4; ++m) _Pragma("unroll") for (int n = 0; n < 2; ++n) _Pragma("unroll") for (int k = 0; k < 2; ++k) \
        acc[ai][bj][m][n] = __builtin_amdgcn_mfma_f32_16x16x32_bf16(Bt[n][k], At[m][k], acc[ai][bj][m][n], 0, 0, 0); __builtin_amdgcn_s_setprio(0); } while (0)
#define PG8_WAIT_V(n) asm volatile("s_waitcnt vmcnt(" #n ")" ::: "memory")
#define PG8_WAIT_L(n) asm volatile("s_waitcnt lgkmcnt(" #n ")" ::: "memory")
#define PG8_BAR __builtin_amdgcn_s_barrier()
#define PG8_SCHED __builtin_amdgcn_sched_barrier(0)
    Unit cur, nxt; int ui = 0;
    if (!S.next(0, cur)) return;
    f32x4 acc[2][2][4][2];
#pragma unroll
    for (int a = 0; a < 2; ++a)
#pragma unroll
        for (int b = 0; b < 2; ++b)
#pragma unroll
            for (int m = 0; m < 4; ++m)
#pragma unroll
                for (int n = 0; n < 2; ++n) acc[a][b][m][n] = (f32x4){0.f, 0.f, 0.f, 0.f};
    bf16x8 At[4][2], B0[2][2], B1[2][2];
    const char* cA = (const char*)g.A + (size_t)cur.pm * tstep; const char* cB = (const char*)g.Bt + (size_t)cur.pn * tstep;
    S.a_ready(cur);
    if constexpr (SP2) {
        PG8_STAGE(PG8_SB(0, 0), cB, voffB); PG8_STAGE(PG8_SB(0, 1), cB + hstep, voffB); PG8_STAGE(PG8_SA(0, 0), cA, voffA); PG8_STAGE(PG8_SA(0, 1), cA + hstep, voffA);
        if (wr == 1) PG8_BAR;
        PG8_WAIT_V(2); PG8_BAR;
        PG8_STAGE(PG8_SB(1, 0), cB + kstep, voffB); PG8_STAGE(PG8_SA(1, 0), cA + kstep, voffA); PG8_STAGE(PG8_SB(1, 1), cB + hstep + kstep, voffB);
        PG8_WAIT_V(6); PG8_BAR;
    } else {
        PG8_STAGE(PG8_SB(0, 0), cB, voffB); PG8_STAGE(PG8_SA(0, 0), cA, voffA); PG8_STAGE(PG8_SB(0, 1), cB + hstep, voffB); PG8_STAGE(PG8_SA(0, 1), cA + hstep, voffA);
        if (wr == 1) PG8_BAR;
        PG8_WAIT_V(4); PG8_BAR;
        PG8_STAGE(PG8_SB(1, 0), cB + kstep, voffB); PG8_STAGE(PG8_SA(1, 0), cA + kstep, voffA); PG8_STAGE(PG8_SB(1, 1), cB + hstep + kstep, voffB);
        PG8_WAIT_V(6); PG8_BAR;
    }
    for (;;) {
        const bool has_next = S.next(ui + 1, nxt);
        const char* nA = has_next ? (const char*)g.A + (size_t)nxt.pm * tstep : cA; const char* nB = has_next ? (const char*)g.Bt + (size_t)nxt.pn * tstep : cB;
        for (int t = 0; t < nt; t += 2) {
            const bool last = (t == nt - 2);
            const char* a1 = cA + (size_t)(t + 1) * kstep;
            const char* a2 = last ? nA : cA + (size_t)(t + 2) * kstep; const char* b2 = last ? nB : cB + (size_t)(t + 2) * kstep;
            const char* a3 = a2 + kstep; const char* b3 = b2 + kstep;
            if (last && has_next) S.a_ready(nxt);
            if constexpr (SP2) {
            PG8_LDB(B0, 0, 0); PG8_LDB(B1, 0, 1); PG8_SCHED; PG8_LDA(At, 0, 0); PG8_STAGE(PG8_SA(1, 1), a1 + hstep, voffA);
            PG8_WAIT_V(8); PG8_WAIT_L(0); PG8_BAR; PG8_MMA(0, 0, At, B0); PG8_MMA(0, 1, At, B1); PG8_BAR; PG8_SCHED;
            PG8_LDA(At, 0, 1); PG8_STAGE(PG8_SB(0, 0), b2, voffB); PG8_STAGE(PG8_SB(0, 1), b2 + hstep, voffB); PG8_STAGE(PG8_SA(0, 0), a2, voffA);
            PG8_WAIT_V(8); PG8_WAIT_L(0); PG8_BAR; PG8_MMA(1, 0, At, B0); PG8_MMA(1, 1, At, B1); PG8_BAR; PG8_SCHED;
            PG8_LDB(B0, 1, 0); PG8_LDB(B1, 1, 1); PG8_SCHED; PG8_LDA(At, 1, 0); PG8_STAGE(PG8_SA(0, 1), a2 + hstep, voffA);
            PG8_WAIT_V(8); PG8_WAIT_L(0); PG8_BAR; PG8_MMA(0, 0, At, B0); PG8_MMA(0, 1, At, B1); PG8_BAR; PG8_SCHED;
            PG8_LDA(At, 1, 1); PG8_STAGE(PG8_SB(1, 0), b3, voffB); PG8_STAGE(PG8_SB(1, 1), b3 + hstep, voffB); PG8_STAGE(PG8_SA(1, 0), a3, voffA);
            PG8_WAIT_V(8); PG8_WAIT_L(0); PG8_BAR; PG8_MMA(1, 0, At, B0); PG8_MMA(1, 1, At, B1); PG8_BAR; PG8_SCHED;
            } else {
            PG8_LDB(B0, 0, 0); PG8_SCHED; PG8_LDA(At, 0, 0); PG8_STAGE(PG8_SA(1, 1), a1 + hstep, voffA);
            PG8_WAIT_L(8); PG8_BAR; PG8_WAIT_L(0); PG8_MMA(0, 0, At, B0); PG8_BAR; PG8_SCHED;
            PG8_LDB(B1, 0, 1); PG8_STAGE(PG8_SB(0, 0), b2, voffB);
            PG8_BAR; PG8_WAIT_L(0); PG8_MMA(0, 1, At, B1); PG8_BAR;
            PG8_LDA(At, 0, 1); PG8_STAGE(PG8_SA(0, 0), a2, voffA);
            PG8_BAR; PG8_WAIT_L(0); PG8_MMA(1, 0, At, B0); PG8_BAR; PG8_SCHED;
            PG8_STAGE(PG8_SB(0, 1), b2 + hstep, voffB);
            PG8_WAIT_V(6); PG8_BAR; PG8_MMA(1, 1, At, B1); PG8_BAR;
            PG8_LDB(B0, 1, 0); PG8_SCHED; PG8_LDA(At, 1, 0); PG8_STAGE(PG8_SA(0, 1), a2 + hstep, voffA);
            PG8_WAIT_L(8); PG8_BAR; PG8_WAIT_L(0); PG8_MMA(0, 0, At, B0); PG8_BAR; PG8_SCHED;
            PG8_LDB(B1, 1, 1); PG8_STAGE(PG8_SB(1, 0), b3, voffB);
            PG8_BAR; PG8_WAIT_L(0); PG8_MMA(0, 1, At, B1); PG8_BAR;
            PG8_LDA(At, 1, 1); PG8_STAGE(PG8_SA(1, 0), a3, voffA);
            PG8_BAR; PG8_WAIT_L(0); PG8_MMA(1, 0, At, B0); PG8_BAR; PG8_SCHED;
            PG8_STAGE(PG8_SB(1, 1), b3 + hstep, voffB);
            PG8_WAIT_V(6); PG8_BAR; PG8_MMA(1, 1, At, B1); PG8_BAR;
            }
        }
        if constexpr (ALIGN_EPI) { if (wr == 0) PG8_BAR; }
        if constexpr (!Epi::AFTER_DRAIN) { E(acc, cur, wr, wc, fr, fq); S.done(cur); }
        if (!has_next) break;
#pragma unroll
        for (int a = 0; a < 2; ++a)
#pragma unroll
            for (int b = 0; b < 2; ++b)
#pragma unroll
                for (int m = 0; m < 4; ++m)
#pragma unroll
                    for (int n = 0; n < 2; ++n) acc[a][b][m][n] = (f32x4){0.f, 0.f, 0.f, 0.f};
        cur = nxt; cA = nA; cB = nB; ++ui;
        if constexpr (ALIGN_EPI) { if (wr == 1) PG8_BAR; }
    }
    PG8_WAIT_V(0);
    if constexpr (!ALIGN_EPI) { if (wr == 0) PG8_BAR; }
    PG8_BAR;
    if constexpr (Epi::AFTER_DRAIN) { E.fused(acc, cur, wr, wc, fr, fq, lds, wid, lane); S.done(cur); }
#undef PG8_SA
#undef PG8_SB
#undef PG8_STAGE
#undef PG8_LDA
#undef PG8_LDB
#undef PG8_MMA
#undef PG8_WAIT_V
#undef PG8_WAIT_L
#undef PG8_BAR
#undef PG8_SCHED
}
}

constexpr int NWAVES = 8, NTHR = NWAVES * 64;
constexpr int BATCH = 8, SEQ = 2048, DM = 1024, DEPTH = 4, NA = 2, NBL = 2, SG = 64, SGC = 16, SP = 64, NH = 16, HD = 64, MBLK = 256, NBLK = SEQ / MBLK, DFF = 2816;
constexpr int M = BATCH * SEQ;
constexpr float C2 = 0.125f * 1.4426950408889634f;
constexpr size_t MiB = 1u << 20;
constexpr size_t WS_CTL = 0, CTL_ZERO_BYTES = 3 * MiB;
constexpr size_t WS_STATS = 1 * MiB;
constexpr size_t WS_KMP = 3 * MiB;
constexpr size_t WS_WIN = 4 * MiB, WIN_BYTES = (size_t)2 * DFF * DM * 2;
constexpr size_t WS_WOUT = WS_WIN + 8 * WIN_BYTES, WOUT_BYTES = (size_t)DM * DFF * 2;
constexpr size_t WS_WGLU = WS_WOUT + 8 * WOUT_BYTES, WGLU_BYTES = (size_t)2 * DM * DM * 2;
constexpr size_t WS_WKV = WS_WGLU + 2 * WGLU_BYTES;
constexpr size_t WS_WQ = WS_WKV + 4 * MiB, WS_WO = WS_WQ + 4 * MiB;
constexpr size_t WS_HB = WS_WO + 4 * MiB;
constexpr size_t WS_ACT = WS_HB + 32 * MiB;
constexpr size_t WS_K = WS_ACT + 88 * MiB, WS_V = WS_K + 32 * MiB, WS_END = WS_V + 32 * MiB;
static_assert(WS_WIN + 8 * WIN_BYTES + 8 * WOUT_BYTES + 2 * WGLU_BYTES + 12 * MiB == WS_HB && WS_HB == 156 * MiB && WS_END == 340 * MiB, "d_ws map");
constexpr int CW_TMO = 0, CW_BAR = 4096;
constexpr int NPHASE = 29;
constexpr int RING_OFF = 0, RING_BYTES = 131072;
constexpr int LDSCTL_OFF = RING_BYTES, MISC_OFF = LDSCTL_OFF + 320;
constexpr int LDS_BYTES = 147456;
#define GAS __attribute__((address_space(1)))
#define LAS __attribute__((address_space(3)))
typedef unsigned short bf16;
typedef unsigned v4u __attribute__((ext_vector_type(4)));
typedef float f32x4 __attribute__((ext_vector_type(4)));
typedef short bf16x8 __attribute__((ext_vector_type(8)));
typedef GAS unsigned gu32;
typedef GAS unsigned long long gu64;
#define RLX_AGENT __ATOMIC_RELAXED, __HIP_MEMORY_SCOPE_AGENT
#define LDS_WAIT() asm volatile("s_waitcnt lgkmcnt(0)" ::: "memory")
#define VM_WAIT() asm volatile("s_waitcnt vmcnt(0)" ::: "memory")
__device__ __forceinline__ unsigned long long rt() { return __builtin_amdgcn_s_memrealtime(); }
__device__ __forceinline__ unsigned f2bf(float f) { unsigned u = __builtin_bit_cast(unsigned, f); return (u + 0x7fffu + ((u >> 16) & 1u)) >> 16; }
__device__ __forceinline__ unsigned pk2(float lo, float hi) { return f2bf(lo) | (f2bf(hi) << 16); }

#define XB_TMO      128
#define XB_XCNT(j)  (256  + 64 * (j))
#define XB_XSUB(j)  (1280 + 64 * (j))
#define XB_XGEN(j)  (2304 + 64 * (j))
#define XB_TOP      3328
#define XB_TOPGEN   3392
#define XCD_BAR_WORDS 3456
#define XB_SPIN_CAP (1u << 18)

__device__ __forceinline__ unsigned xb_ld(unsigned* p)              { return __hip_atomic_load(p, __ATOMIC_RELAXED, __HIP_MEMORY_SCOPE_AGENT); }
__device__ __forceinline__ unsigned xb_add(unsigned* p, unsigned v) { return __hip_atomic_fetch_add(p, v, __ATOMIC_RELAXED, __HIP_MEMORY_SCOPE_AGENT); }
__device__ __forceinline__ unsigned xb_xcc_id() { return (unsigned)__builtin_amdgcn_s_getreg((3 << 11) | 20) & 0xFu; }
#define XB_SPIN(cond, bar) do { unsigned _sp = 0; while (cond) { __builtin_amdgcn_s_sleep(1); \
    if ((++_sp & 255u) == 0u) { if (xb_ld(&(bar)[XB_TMO])) break; if (_sp > XB_SPIN_CAP) { atomicAdd(&(bar)[XB_TMO], 1u); break; } } } } while (0)

struct XcdBarrier {
    unsigned* bar; unsigned x;
    volatile LAS unsigned* st;
};

__device__ __forceinline__ XcdBarrier xcd_barrier_post(unsigned* bar, volatile LAS unsigned* st) {
    XcdBarrier b; b.bar = bar; b.x = xb_xcc_id(); b.st = st;
    if (threadIdx.x == 0) (void)xb_add(&bar[XB_XCNT(b.x)], 1u);
    return b;
}
__device__ __forceinline__ void xcd_barrier_complete(unsigned* bar, unsigned x, unsigned& nloc, unsigned& nx) {
    const unsigned G = gridDim.x * gridDim.y * gridDim.z;
    unsigned sum, cnt, mine, sp = 0u;
    for (;;) {
        sum = 0u; cnt = 0u; mine = 0u;
#pragma unroll
        for (unsigned j = 0; j < 16; ++j) { const unsigned c = xb_ld(&bar[XB_XCNT(j)]); sum += c; cnt += (c > 0u) ? 1u : 0u; mine = (j == x) ? c : mine; }
        if (sum == G) break;
        __builtin_amdgcn_s_sleep(1);
        if ((++sp & 255u) == 0u) { if (xb_ld(&bar[XB_TMO])) break; if (sp > XB_SPIN_CAP) { atomicAdd(&bar[XB_TMO], 1u); break; } }
    }
    nloc = mine > 0u ? mine : 1u; nx = cnt > 0u ? cnt : 1u;
}

__device__ __forceinline__ void xcd_barrier(const XcdBarrier& b) {
    asm volatile("s_waitcnt vmcnt(0)" ::: "memory");
    __syncthreads();
    if (threadIdx.x == 0) {
        unsigned* bar = b.bar;
        __builtin_amdgcn_s_waitcnt(0);
        unsigned nloc = b.st[0], nx = b.st[1];
        if (nloc == 0u) { xcd_barrier_complete(bar, b.x, nloc, nx); b.st[0] = nloc; b.st[1] = nx; }
        const unsigned old = xb_add(&bar[XB_XSUB(b.x)], 1u);
        const unsigned gen = old / nloc;
        if (old + 1u == (gen + 1u) * nloc) {
            __builtin_amdgcn_fence(__ATOMIC_RELEASE, "agent");
            asm volatile("s_waitcnt vmcnt(0)" ::: "memory");
            const unsigned og = xb_add(&bar[XB_TOP], 1u);
            const unsigned tg = og / nx;
            if (og + 1u == (tg + 1u) * nx) xb_add(&bar[XB_TOPGEN], 1u);
            else XB_SPIN(xb_ld(&bar[XB_TOPGEN]) == tg, bar);
            __builtin_amdgcn_fence(__ATOMIC_ACQUIRE, "agent");
            xb_add(&bar[XB_XGEN(b.x)], 1u);
            asm volatile("s_waitcnt vmcnt(0)" ::: "memory");
        } else {
            XB_SPIN(xb_ld(&bar[XB_XGEN(b.x)]) == gen, bar);
            __builtin_amdgcn_fence(__ATOMIC_ACQUIRE, "agent");
            asm volatile("s_waitcnt vmcnt(0)" ::: "memory");
        }
    }
    __syncthreads();
}

typedef unsigned v2u __attribute__((ext_vector_type(2)));
__device__ __forceinline__ float bf_lo(unsigned w) { return __builtin_bit_cast(float, w << 16); }
__device__ __forceinline__ float bf_hi(unsigned w) { return __builtin_bit_cast(float, w & 0xffff0000u); }
__device__ __forceinline__ float wave_sum(float v) {
#pragma unroll
    for (int o = 1; o < 64; o <<= 1) v += __shfl_xor(v, o);
    return v;
}
__device__ __forceinline__ void p0_transpose_item(const float* W, int ldw, int srccol0, const float* gain, bf16* WT, int K, int n0, int k0, LAS float* scr, int lane) {
#pragma unroll 8
    for (int i = 0; i < 32; ++i) { const int kk = 2 * i + (lane >> 5); float v = W[(size_t)(k0 + kk) * ldw + srccol0 + (lane & 31)]; if (gain) v *= gain[k0 + kk]; scr[kk * 33 + (lane & 31)] = v; }
    LDS_WAIT(); asm volatile("" ::: "memory");
    const int c = lane & 7;
#pragma unroll
    for (int j = 0; j < 4; ++j) { const int n = (lane >> 3) + 8 * j; const LAS float* s = scr + (8 * c) * 33 + n;
        v4u o; o.x = pk2(s[0 * 33], s[1 * 33]); o.y = pk2(s[2 * 33], s[3 * 33]); o.z = pk2(s[4 * 33], s[5 * 33]); o.w = pk2(s[6 * 33], s[7 * 33]);
        *(v4u*)(WT + (size_t)(n0 + n) * K + k0 + 8 * c) = o; }
    LDS_WAIT(); asm volatile("" ::: "memory");
}
__device__ __forceinline__ int il_col(int n0, int Hn) { const int t = n0 >> 8, w = n0 & 255; return (w < 128) ? t * 128 + w : Hn + t * 128 + (w - 128); }

struct Args { const float* in[22]; float* out; unsigned char* ws; int ph_lo, ph_hi; };

__device__ __forceinline__ void phase_prologue(const Args& a, LAS unsigned char* lds, int vcu, int G) {
    int tid_o = threadIdx.x; asm volatile("" : "+v"(tid_o)); const int lane = tid_o & 63, wave = __builtin_amdgcn_readfirstlane(tid_o >> 6);
    LAS float* scr = (LAS float*)(lds + RING_OFF + wave * 16384);
    const int gw = vcu * NWAVES + wave, NGW = G * NWAVES;
    constexpr int I_IN = (DM / 64) * (2 * DFF / 32), I_OUT = (DFF / 64) * (DM / 32), I_GLU = (DM / 64) * (2 * DM / 32), I_KV = I_GLU, I_SQ = (DM / 64) * (DM / 32);
    constexpr int T_IN = 8 * I_IN, T_OUT = 8 * I_OUT, T_GLU = 2 * I_GLU, T_KV = I_KV, T_Q = 2 * I_SQ, T_O = 2 * I_SQ, NITEMS = T_IN + T_OUT + T_GLU + T_KV + T_Q + T_O;
    unsigned char* ws = a.ws;
    for (int it = gw; it < NITEMS; it += NGW) {
        int r = it;
        if (r < T_IN) { const int j = r / I_IN, q = r % I_IN, l = j >> 1, f = j & 1; const int nblk = 2 * DFF / 32, kb = q / nblk, nb = q % nblk, n0 = 32 * nb;
            p0_transpose_item(a.in[f ? 6 : 2] + (size_t)l * DM * 2 * DFF, 2 * DFF, il_col(n0, DFF), a.in[f ? 5 : 1] + l * DM, (bf16*)(ws + WS_WIN + (size_t)j * WIN_BYTES), DM, n0, 64 * kb, scr, lane); continue; } r -= T_IN;
        if (r < T_OUT) { const int j = r / I_OUT, q = r % I_OUT, l = j >> 1, f = j & 1; const int nblk = DM / 32, kb = q / nblk, nb = q % nblk, n0 = 32 * nb;
            p0_transpose_item(a.in[f ? 7 : 3] + (size_t)l * DFF * DM, DM, n0, nullptr, (bf16*)(ws + WS_WOUT + (size_t)j * WOUT_BYTES), DFF, n0, 64 * kb, scr, lane); continue; } r -= T_OUT;
        if (r < T_GLU) { const int l = r / I_GLU, q = r % I_GLU; const int nblk = 2 * DM / 32, kb = q / nblk, nb = q % nblk, n0 = 32 * nb;
            p0_transpose_item(a.in[16] + (size_t)l * DM * 2 * DM, 2 * DM, il_col(n0, DM), nullptr, (bf16*)(ws + WS_WGLU + (size_t)l * WGLU_BYTES), DM, n0, 64 * kb, scr, lane); continue; } r -= T_GLU;
        if (r < T_KV) { const int q = r; const int nblk = 2 * DM / 32, kb = q / nblk, nb = q % nblk, n0 = 32 * nb;
            p0_transpose_item(a.in[18], 2 * DM, n0, a.in[17], (bf16*)(ws + WS_WKV), DM, n0, 64 * kb, scr, lane); continue; } r -= T_KV;
        if (r < T_Q) { const int l = r / I_SQ, q = r % I_SQ; const int nblk = DM / 32, kb = q / nblk, nb = q % nblk, n0 = 32 * nb;
            p0_transpose_item(a.in[19] + (size_t)l * DM * DM, DM, n0, a.in[4] + (NA + l) * DM, (bf16*)(ws + WS_WQ + (size_t)l * 2 * MiB), DM, n0, 64 * kb, scr, lane); continue; } r -= T_Q;
        { const int l = r / I_SQ, q = r % I_SQ; const int nblk = DM / 32, kb = q / nblk, nb = q % nblk, n0 = 32 * nb;
            p0_transpose_item(a.in[20] + (size_t)l * DM * DM, DM, n0, nullptr, (bf16*)(ws + WS_WO + (size_t)l * 2 * MiB), DM, n0, 64 * kb, scr, lane); }
    }
    const float* x = a.in[0]; bf16* hb = (bf16*)(ws + WS_HB); pg8::stat_t* st0 = (pg8::stat_t*)(ws + WS_STATS);
    for (int m = gw; m < M; m += NGW) {
        const f32x4* xr = (const f32x4*)(x + (size_t)m * DM) + lane; unsigned long long* o8 = (unsigned long long*)(hb + (size_t)m * DM) + lane; float s = 0.f;
#pragma unroll
        for (int j = 0; j < 4; ++j) { const f32x4 v = xr[64 * j]; s += (v.x * v.x + v.y * v.y) + (v.z * v.z + v.w * v.w); o8[64 * j] = (unsigned long long)pk2(v.x, v.y) | ((unsigned long long)pk2(v.z, v.w) << 32); }
        s = wave_sum(s); if (lane == 0) st0[m] = (pg8::stat_t)(s * 4294967296.0f);
    }
}
__device__ __forceinline__ void phase_final(const Args& a, int vcu, int G) {
    int tid_o = threadIdx.x; asm volatile("" : "+v"(tid_o)); const int lane = tid_o & 63, wave = __builtin_amdgcn_readfirstlane(tid_o >> 6);
    const int gw = vcu * NWAVES + wave, NGW = G * NWAVES; const float* gn = a.in[21];
    f32x4 g[4];
#pragma unroll
    for (int j = 0; j < 4; ++j) g[j] = ((const f32x4*)gn)[lane + 64 * j];
    for (int m = gw; m < M; m += NGW) {
        f32x4* xr = (f32x4*)(a.out + (size_t)m * DM) + lane; f32x4 v[4]; float s = 0.f;
#pragma unroll
        for (int j = 0; j < 4; ++j) { v[j] = xr[64 * j]; s += (v[j].x * v[j].x + v[j].y * v[j].y) + (v[j].z * v[j].z + v[j].w * v[j].w); }
        const float r = rsqrtf(wave_sum(s) * (1.0f / DM) + 1e-6f);
#pragma unroll
        for (int j = 0; j < 4; ++j) xr[64 * j] = v[j] * r * g[j];
    }
}
__device__ __forceinline__ float gelu_tanh(float x) { const float t = 0.7978845608028654f * (x + 0.044715f * x * x * x); return x * __builtin_amdgcn_rcpf(1.0f + __builtin_amdgcn_exp2f(-2.0f * 1.4426950408889634f * t)); }
__device__ __forceinline__ void sincos_f(float ang, float& s, float& c) {
    const float q = __builtin_rintf(ang * 0.63661977236758134308f);
    float r = __builtin_fmaf(-q, 1.5707855225e+00f, ang); r = __builtin_fmaf(-q, 1.0804334124e-05f, r); const float r2 = r * r;
    float sp = 2.7557319223985893e-06f; sp = sp * r2 - 1.9841269841269841e-04f; sp = sp * r2 + 8.3333333333333332e-03f; sp = sp * r2 - 1.6666666666666666e-01f; const float sr = r + r * r2 * sp;
    float cp = 2.4801587301587302e-05f; cp = cp * r2 - 1.3888888888888889e-03f; cp = cp * r2 + 4.1666666666666664e-02f; cp = cp * r2 - 0.5f; const float cr = 1.0f + r2 * cp;
    const int qi = ((int)q) & 3;
    s = (qi == 0) ? sr : (qi == 1) ? cr : (qi == 2) ? -sr : -cr; c = (qi == 0) ? cr : (qi == 1) ? -sr : (qi == 2) ? -cr : sr;
}
constexpr int S5_T = 128, S5_XP = 132;
__device__ __forceinline__ void phase_s5_simple(const Args& a, LAS unsigned char* lds, int layer, const pg8::stat_t* stats, int G) {
    int tid_o = threadIdx.x; asm volatile("" : "+v"(tid_o)); const int tid = tid_o, lane = tid_o & 63, wave = __builtin_amdgcn_readfirstlane(tid_o >> 6);
    LAS float* us = (LAS float*)(lds);
    LAS float* xs = (LAS float*)(lds + 8192);
    LAS float* cs = (LAS float*)(lds + 8192 + S5_T * S5_XP * 4);
    const float* h = a.out; bf16* z = (bf16*)(a.ws + WS_ACT);
    const float* gain = a.in[4] + layer * DM;
    for (int u = blockIdx.x; u < BATCH * SG; u += G) {
        const int b = u / SG, g = u % SG;
        float lr = 0.f, li = 0.f, bbr[16], bbi[16];
        if (wave == 0) {
            const int p = lane; const float dt = expf(a.in[15][layer * SG + g]);
            const float ar = fminf(a.in[8][(layer * SG + g) * SP + p], -1e-4f), ai = a.in[9][(layer * SG + g) * SP + p];
            const float mag = expf(ar * dt); float sn, cn; sincos_f(ai * dt, sn, cn);
            lr = mag * cn; li = mag * sn;
            const float nr = lr - 1.0f, den = ar * ar + ai * ai, fr = (nr * ar + li * ai) / den, fi = (li * ar - nr * ai) / den;
            const float* br = a.in[10] + ((size_t)(layer * SG + g) * SP + p) * SGC; const float* bi = a.in[11] + ((size_t)(layer * SG + g) * SP + p) * SGC;
#pragma unroll
            for (int j = 0; j < 16; ++j) { bbr[j] = fr * br[j] - fi * bi[j]; bbi[j] = fr * bi[j] + fi * br[j]; }
        }
        for (int i = tid; i < 16 * 128; i += NTHR) { const int j = i >> 7, pp = i & 127; const float v = (pp < 64) ? a.in[12][((size_t)(layer * SG + g) * SGC + j) * SP + pp] : -a.in[13][((size_t)(layer * SG + g) * SGC + j) * SP + (pp - 64)]; cs[j * S5_XP + pp] = v; }
        float xr = 0.f, xi = 0.f;
        for (int t0 = 0; t0 < SEQ; t0 += S5_T) {
            { const int t = tid >> 2, j4 = (tid & 3) * 4; const int row = b * SEQ + t0 + t; const float r = pg8::rstd_of(stats, row);
              const f32x4 v = *(const f32x4*)(h + (size_t)row * DM + g * SGC + j4); const f32x4 gv = *(const f32x4*)(gain + g * SGC + j4);
              *(LAS f32x4*)(us + t * 16 + j4) = v * r * gv; }
            __syncthreads();
            if (wave == 0) {
                for (int t = 0; t < S5_T; ++t) {
                    const f32x4 u0 = *(LAS f32x4*)(us + t * 16), u1 = *(LAS f32x4*)(us + t * 16 + 4), u2 = *(LAS f32x4*)(us + t * 16 + 8), u3 = *(LAS f32x4*)(us + t * 16 + 12);
                    const float uu[16] = {u0.x, u0.y, u0.z, u0.w, u1.x, u1.y, u1.z, u1.w, u2.x, u2.y, u2.z, u2.w, u3.x, u3.y, u3.z, u3.w};
                    float br_ = 0.f, bi_ = 0.f;
#pragma unroll
                    for (int j = 0; j < 16; ++j) { br_ += bbr[j] * uu[j]; bi_ += bbi[j] * uu[j]; }
                    const float nxr = lr * xr - li * xi + br_, nxi = lr * xi + li * xr + bi_; xr = nxr; xi = nxi;
                    xs[t * S5_XP + lane] = xr; xs[t * S5_XP + 64 + lane] = xi;
                }
            }
            __syncthreads();
            { const int t = tid >> 2, j4 = (tid & 3) * 4; float y[4] = {0.f, 0.f, 0.f, 0.f};
              for (int p4 = 0; p4 < 128; p4 += 4) { const f32x4 xv = *(LAS f32x4*)(xs + t * S5_XP + p4);
#pragma unroll
                  for (int jj = 0; jj < 4; ++jj) { const f32x4 cv = *(LAS f32x4*)(cs + (j4 + jj) * S5_XP + p4); y[jj] += (xv.x * cv.x + xv.y * cv.y) + (xv.z * cv.z + xv.w * cv.w); } }
              const f32x4 uv = *(LAS f32x4*)(us + t * 16 + j4); const f32x4 dv = *(const f32x4*)(a.in[14] + layer * DM + g * SGC + j4);
              const float z0 = gelu_tanh(y[0] + dv.x * uv.x), z1 = gelu_tanh(y[1] + dv.y * uv.y), z2 = gelu_tanh(y[2] + dv.z * uv.z), z3 = gelu_tanh(y[3] + dv.w * uv.w);
              const int row = b * SEQ + t0 + t; v2u w; w.x = pk2(z0, z1); w.y = pk2(z2, z3); *(v2u*)(z + (size_t)row * DM + g * SGC + j4) = w; }
            __syncthreads();
        }
    }
}
constexpr int AT_KT = 128;
__device__ __forceinline__ void phase_attn_simple(const Args& a, LAS unsigned char* lds, int G) {
    int tid_o = threadIdx.x; asm volatile("" : "+v"(tid_o)); const int tid = tid_o;
    LAS float* ks = (LAS float*)(lds);
    LAS float* vs = (LAS float*)(lds + 32768);
    LAS float* km = (LAS float*)(lds + 65536);
    const bf16* Q = (const bf16*)(a.ws + WS_ACT); bf16* O = (bf16*)(a.ws + WS_ACT + 32 * MiB);
    const bf16* K = (const bf16*)(a.ws + WS_K); const bf16* V = (const bf16*)(a.ws + WS_V); const float* kmp = (const float*)(a.ws + WS_KMP);
    for (int u = blockIdx.x; u < BATCH * NH * NBLK; u += G) {
        const int kq = u >> 8, c = u & 255, bh = c >> 1, qb = (c & 1) ? ((kq == 0) ? 2 : (kq == 1) ? 5 : (kq == 2) ? 3 : 4) : ((kq == 0) ? 0 : (kq == 1) ? 7 : (kq == 2) ? 1 : 6);
        const int b = bh >> 4, hh = bh & 15; const int qi = tid >> 1, half = tid & 1, t = qb * MBLK + qi; const size_t row = (size_t)b * SEQ + t;
        const float slope2 = exp2f(-0.5f * (float)(hh + 1)) * 1.4426950408889634f;
        { const int n = tid >> 6, d = tid & 63; km[n * 64 + d] = (kmp[((size_t)(b * NBLK + n)) * DM + hh * HD + d] + kmp[((size_t)64 * DM) + ((size_t)(b * NBLK + n)) * DM + hh * HD + d]) * (1.0f / 256.0f); }
        float q[32], o[32];
        { const v4u* qp = (const v4u*)(Q + row * DM + hh * HD + half * 32);
#pragma unroll
          for (int i = 0; i < 4; ++i) { const v4u w = qp[i]; q[8 * i + 0] = bf_lo(w.x); q[8 * i + 1] = bf_hi(w.x); q[8 * i + 2] = bf_lo(w.y); q[8 * i + 3] = bf_hi(w.y); q[8 * i + 4] = bf_lo(w.z); q[8 * i + 5] = bf_hi(w.z); q[8 * i + 6] = bf_lo(w.w); q[8 * i + 7] = bf_hi(w.w); } }
#pragma unroll
        for (int d = 0; d < 32; ++d) o[d] = 0.f;
        __syncthreads();
        unsigned sel = 0u;
        { float gt[8];
#pragma unroll
          for (int n = 0; n < 8; ++n) { float s = 0.f;
#pragma unroll
              for (int d = 0; d < 32; ++d) s += q[d] * km[n * 64 + half * 32 + d];
              s += __shfl_xor(s, 1); gt[n] = (n < qb) ? s : -3.0e38f; }
          const int nsel = qb < 3 ? qb : 3;
          for (int r = 0; r < nsel; ++r) { float best = -3.0e38f; int bi = 0;
#pragma unroll
              for (int n = 0; n < 8; ++n) { const bool ok = (n < qb) && !((sel >> n) & 1u) && (gt[n] > best); if (ok) { best = gt[n]; bi = n; } }
              sel |= 1u << bi; } }
        float mx = -1.0e30f, l = 0.f;
        for (int nb = 0; nb <= qb; ++nb) {
            for (int kt = 0; kt < MBLK; kt += AT_KT) {
                __syncthreads();
                { const int key = tid >> 2, ds = (tid & 3) * 16; const size_t kr = ((size_t)b * SEQ + nb * MBLK + kt + key) * DM + hh * HD + ds;
#pragma unroll
                  for (int i = 0; i < 2; ++i) { const v4u w = *(const v4u*)(K + kr + 8 * i); const v4u x = *(const v4u*)(V + kr + 8 * i);
                      *(LAS f32x4*)(ks + key * 64 + ds + 8 * i) = (f32x4){bf_lo(w.x), bf_hi(w.x), bf_lo(w.y), bf_hi(w.y)}; *(LAS f32x4*)(ks + key * 64 + ds + 8 * i + 4) = (f32x4){bf_lo(w.z), bf_hi(w.z), bf_lo(w.w), bf_hi(w.w)};
                      *(LAS f32x4*)(vs + key * 64 + ds + 8 * i) = (f32x4){bf_lo(x.x), bf_hi(x.x), bf_lo(x.y), bf_hi(x.y)}; *(LAS f32x4*)(vs + key * 64 + ds + 8 * i + 4) = (f32x4){bf_lo(x.z), bf_hi(x.z), bf_lo(x.w), bf_hi(x.w)}; } }
                __syncthreads();
                const bool own = (nb == qb); const bool use = own || ((sel >> nb) & 1u);
                if (use) {
                    const int kpos0 = nb * MBLK + kt; int kend = AT_KT; if (own) { const int lim = t - kpos0 + 1; kend = lim < kend ? lim : kend; }
                    for (int k8 = 0; k8 < kend; k8 += 4) {
                        float s[4]; float mc = -1.0e30f;
#pragma unroll
                        for (int kk = 0; kk < 4; ++kk) { const LAS float* kp = ks + (k8 + kk) * 64 + half * 32; float p = 0.f;
#pragma unroll
                            for (int d4 = 0; d4 < 8; ++d4) { const f32x4 kv = *(const LAS f32x4*)(kp + 4 * d4); p += (q[4 * d4] * kv.x + q[4 * d4 + 1] * kv.y) + (q[4 * d4 + 2] * kv.z + q[4 * d4 + 3] * kv.w); }
                            p += __shfl_xor(p, 1);
                            const int kpos = kpos0 + k8 + kk; p -= slope2 * (float)(t - kpos); if (k8 + kk >= kend) p = -1.0e30f; s[kk] = p; mc = fmaxf(mc, p); asm volatile("" : "+v"(p)); }
                        if (mc > mx) { const float al = exp2f(mx - mc); l *= al;
#pragma unroll
                            for (int d = 0; d < 32; ++d) o[d] *= al;
                            mx = mc; }
#pragma unroll
                        for (int kk = 0; kk < 4; ++kk) { const float p = exp2f(s[kk] - mx); l += p; const LAS float* vp = vs + (k8 + kk) * 64 + half * 32;
#pragma unroll
                            for (int d4 = 0; d4 < 8; ++d4) { const f32x4 vv = *(const LAS f32x4*)(vp + 4 * d4); o[4 * d4] += p * vv.x; o[4 * d4 + 1] += p * vv.y; o[4 * d4 + 2] += p * vv.z; o[4 * d4 + 3] += p * vv.w; }
                            asm volatile("" ::: "memory"); }
                    }
                }
            }
        }
        { const float il = 1.0f / l; v4u* op = (v4u*)(O + row * DM + hh * HD + half * 32);
#pragma unroll
          for (int i = 0; i < 4; ++i) { v4u w; w.x = pk2(o[8 * i] * il, o[8 * i + 1] * il); w.y = pk2(o[8 * i + 2] * il, o[8 * i + 3] * il); w.z = pk2(o[8 * i + 4] * il, o[8 * i + 5] * il); w.w = pk2(o[8 * i + 6] * il, o[8 * i + 7] * il); op[i] = w; } }
        __syncthreads();
    }
}
template <class T> __device__ __forceinline__ T* opq(T* p) { size_t z = 0; asm volatile("" : "+s"(z)); return (T*)((unsigned char*)p + z); }
#ifndef MK_ONE_LAUNCH
#define MK_ONE_LAUNCH 0
#endif
__global__ void __launch_bounds__(NTHR, 2) mk_fwd(Args a) {
    extern __shared__ __attribute__((aligned(16))) unsigned char lds_raw[];
    LAS unsigned char* lds = (LAS unsigned char*)lds_raw;
    volatile LAS unsigned* MISC = (volatile LAS unsigned*)(lds + MISC_OFF);
    const int tid = threadIdx.x, lane = tid & 63, wave = __builtin_amdgcn_readfirstlane(tid >> 6);
    const int G = gridDim.x; const int bx = blockIdx.x; const int vcu = (G % 8 == 0) ? (bx % 8) * (G / 8) + bx / 8 : bx;
    gu32* ctl = (gu32*)(a.ws + WS_CTL);
    for (int u = tid; u < (LDS_BYTES - LDSCTL_OFF) / 4; u += NTHR) ((LAS unsigned*)(lds + LDSCTL_OFF))[u] = 0u;
    __syncthreads();
    const int lo = a.ph_lo, hi = a.ph_hi; const bool multi = (hi - lo) > 1;
    XcdBarrier bar; bar.bar = (unsigned*)(ctl + CW_BAR); bar.x = 0; bar.st = nullptr;
    if (multi) bar = xcd_barrier_post((unsigned*)(ctl + CW_BAR), MISC + 8);
    int pid = 0;
#define IN_PH() (lo <= pid && pid < hi)
#define END_PH() do { if (IN_PH() && pid + 1 < hi) xcd_barrier(bar); ++pid; } while (0)
    #ifndef NO_PRO
    if (IN_PH()) phase_prologue(a, lds, vcu, G);
#endif
    END_PH();
    int sidx = 0;
#pragma nounroll
    for (int l = 0; l < DEPTH; ++l) {
#pragma nounroll
        for (int sub = 0; sub < 3; ++sub) {
            if (sub != 1) {
                const int f = sub >> 1, j = 2 * l + f;
                if (IN_PH()) { unsigned char* ws = opq(a.ws); pg8::stat_t* stats = (pg8::stat_t*)(ws + WS_STATS); bf16* hb = (bf16*)(ws + WS_HB); bf16* act = (bf16*)(ws + WS_ACT); (void)stats; (void)hb; (void)act; pg8::Gemm g{hb, (const bf16*)(ws + WS_WIN + (size_t)j * WIN_BYTES), M, 2 * DFF, DM}; pg8::StaticOrder S; S.init(M, 2 * DFF, G, bx);
                    pg8::EpiSwiGLU E{act, DFF, stats + (size_t)sidx * M};
                    pg8::gemm_phase<pg8::EpiSwiGLU, pg8::StaticOrder, true, true>(lds + RING_OFF, g, S, E); }
                END_PH();
                if (IN_PH()) { unsigned char* ws = opq(a.ws); pg8::stat_t* stats = (pg8::stat_t*)(ws + WS_STATS); bf16* hb = (bf16*)(ws + WS_HB); bf16* act = (bf16*)(ws + WS_ACT); (void)stats; (void)hb; (void)act; pg8::Gemm g{act, (const bf16*)(ws + WS_WOUT + (size_t)j * WOUT_BYTES), M, DM, DFF}; pg8::StaticOrder S; S.init(M, DM, G, bx);
                    pg8::EpiRes E{(l == 0 && sub == 0) ? a.in[0] : a.out, a.out, hb, stats + (size_t)(sidx + 1) * M, 0.5f};
                    pg8::gemm_phase<pg8::EpiRes, pg8::StaticOrder, true, true>(lds + RING_OFF, g, S, E); }
                END_PH(); ++sidx;
            } else if (l < NA) {
                #ifndef NO_S5
                if (IN_PH()) phase_s5_simple(a, lds, l, (const pg8::stat_t*)(opq(a.ws) + WS_STATS) + (size_t)sidx * M, G);
#endif
                END_PH();
                if (IN_PH()) { unsigned char* ws = opq(a.ws); pg8::stat_t* stats = (pg8::stat_t*)(ws + WS_STATS); bf16* hb = (bf16*)(ws + WS_HB); bf16* act = (bf16*)(ws + WS_ACT); (void)stats; (void)hb; (void)act; pg8::Gemm g{act, (const bf16*)(ws + WS_WGLU + (size_t)l * WGLU_BYTES), M, 2 * DM, DM}; pg8::StaticOrder S; S.init(M, 2 * DM, G, bx);
                    pg8::EpiGluRes E{a.out, a.out, hb, stats + (size_t)(sidx + 1) * M};
                    pg8::gemm_phase<pg8::EpiGluRes, pg8::StaticOrder, true, true>(lds + RING_OFF, g, S, E); }
                END_PH(); ++sidx;
            } else {
                const int jb = l - NA;
                if (IN_PH()) { unsigned char* ws = opq(a.ws); pg8::stat_t* stats = (pg8::stat_t*)(ws + WS_STATS); bf16* hb = (bf16*)(ws + WS_HB); bf16* act = (bf16*)(ws + WS_ACT); (void)stats; (void)hb; (void)act; pg8::Gemm g{hb, (const bf16*)(ws + WS_WQ + (size_t)jb * 2 * MiB), M, DM, DM}; pg8::StaticOrder S; S.init(M, DM, G, bx);
                    pg8::EpiRowScale<false> E{act, act, stats + (size_t)sidx * M, C2, nullptr};
                    pg8::gemm_phase<pg8::EpiRowScale<false>, pg8::StaticOrder, true, true>(lds + RING_OFF, g, S, E); }
                END_PH();
                #ifndef NO_ATT
                if (IN_PH()) phase_attn_simple(a, lds, G);
#endif
                END_PH();
                if (IN_PH()) { unsigned char* ws = opq(a.ws); pg8::stat_t* stats = (pg8::stat_t*)(ws + WS_STATS); bf16* hb = (bf16*)(ws + WS_HB); bf16* act = (bf16*)(ws + WS_ACT); (void)stats; (void)hb; (void)act; pg8::Gemm g{(const bf16*)(ws + WS_ACT + 32 * MiB), (const bf16*)(ws + WS_WO + (size_t)jb * 2 * MiB), M, DM, DM}; pg8::StaticOrder S; S.init(M, DM, G, bx);
                    pg8::EpiRes E{a.out, a.out, hb, stats + (size_t)(sidx + 1) * M, 1.0f};
                    pg8::gemm_phase<pg8::EpiRes, pg8::StaticOrder, true, true>(lds + RING_OFF, g, S, E); }
                END_PH(); ++sidx;
            }
            if (l == NA - 1 && sub == 2) {
                if (IN_PH()) { unsigned char* ws = opq(a.ws); pg8::stat_t* stats = (pg8::stat_t*)(ws + WS_STATS); bf16* hb = (bf16*)(ws + WS_HB); bf16* act = (bf16*)(ws + WS_ACT); (void)stats; (void)hb; (void)act; pg8::Gemm g{hb, (const bf16*)(ws + WS_WKV), M, 2 * DM, DM}; pg8::StaticOrder S; S.init(M, 2 * DM, G, bx);
                    pg8::EpiRowScale<true> E{(bf16*)(ws + WS_K), (bf16*)(ws + WS_V), stats + (size_t)sidx * M, 1.0f, (float*)(ws + WS_KMP)};
                    pg8::gemm_phase<pg8::EpiRowScale<true>, pg8::StaticOrder, true, true>(lds + RING_OFF, g, S, E); }
                END_PH();
            }
        }
    }
    #ifndef NO_FIN
    if (IN_PH()) phase_final(a, vcu, G);
#endif
    ++pid;
#undef IN_PH
#undef END_PH
}

extern "C" void kernel_launch(void* const* d_in, const int* in_sizes, int n_in, void* d_out, int out_size, void* d_ws, size_t ws_size, hipStream_t stream) {
    static int grid = 0;
    if (grid == 0) {
        if (n_in != 22 || in_sizes[0] != M * DM || out_size != M * DM || ws_size < WS_END) { fprintf(stderr, "kernel_launch: unexpected shapes / workspace (n_in %d, ws %zu < %zu); nothing launched\n", n_in, ws_size, (size_t)WS_END); grid = -1; return; }
        int dev = 0, cus = 0, per_cu = 0;
        if (hipGetDevice(&dev) != hipSuccess || hipDeviceGetAttribute(&cus, hipDeviceAttributeMultiprocessorCount, dev) != hipSuccess) { grid = -1; return; }
        if (hipFuncSetAttribute((const void*)mk_fwd, hipFuncAttributeMaxDynamicSharedMemorySize, LDS_BYTES) != hipSuccess) { fprintf(stderr, "kernel_launch: hipFuncSetAttribute failed\n"); grid = -1; return; }
        if (hipOccupancyMaxActiveBlocksPerMultiprocessor(&per_cu, (const void*)mk_fwd, NTHR, LDS_BYTES) != hipSuccess || per_cu < 1) fprintf(stderr, "kernel_launch: occupancy query reports %d\n", per_cu);
        (void)hipGetLastError();
        grid = cus;
    }
    if (grid < 0) return;
    if (hipMemsetAsync((char*)d_ws + WS_CTL, 0, CTL_ZERO_BYTES, stream) != hipSuccess) return;
    Args a{};
    for (int i = 0; i < 22; ++i) a.in[i] = (const float*)d_in[i];
    a.out = (float*)d_out; a.ws = (unsigned char*)d_ws;
#if MK_ONE_LAUNCH
    a.ph_lo = 0; a.ph_hi = NPHASE;
    hipLaunchKernelGGL(mk_fwd, dim3(grid), dim3(NTHR), LDS_BYTES, stream, a);
#else
    for (int p = 0; p < NPHASE; ++p) { a.ph_lo = p; a.ph_hi = p + 1; hipLaunchKernelGGL(mk_fwd, dim3(grid), dim3(NTHR), LDS_BYTES, stream, a); }
#endif
}
```

```cpp
#include <hip/hip_runtime.h>
#include <cstdio>
#include <cstdint>
namespace pg8 {
#define PG8_LAS __attribute__((address_space(3)))
typedef unsigned short bf16_t;
typedef short bf16x8 __attribute__((ext_vector_type(8)));
typedef float f32x4 __attribute__((ext_vector_type(4)));
typedef unsigned u32x4 __attribute__((ext_vector_type(4)));
constexpr int BM = 256, BK = 64, HALF = 128, HTB = HALF * BK * 2  , STAGE_BYTES = 8 * HTB, NXCD = 8, WGM = 8;

__host__ __device__ __forceinline__ int lds_byte(int r, int c) { const int st = (r >> 4) * 2 + (c >> 5), rr = r & 15, cc = c & 31, ob = rr * 64 + cc * 2; return st * 1024 + (ob ^ (((ob >> 9) & 1) << 5)); }
__host__ __device__ __forceinline__ void stage_rc(int b, int& R, int& C) { const int st = b / 1024, sb = b % 1024, swz = sb ^ (((sb >> 9) & 1) << 5); R = (st >> 1) * 16 + swz / 64; C = (st & 1) * 32 + (swz % 64) / 2; }
__host__ __device__ __forceinline__ int perm32(int rho) { const int n = rho >> 4, i = rho & 15; return 8 * (i >> 2) + 4 * n + (i & 3); }

struct Unit { int pm, pn; };
struct Gemm { const bf16_t* A; const bf16_t* Bt; int M, N, K; };

struct StaticOrder {
    int nM, nN, nwg, G, c;
    __host__ __device__ void init(int M, int N, int G_, int c_) { nM = M / BM; nN = N / BM; nwg = nM * nN; G = G_; c = c_; }
    __host__ __device__ bool next(int i, Unit& u) const {
        const long L = (long)i * G + c; if (L >= nwg) return false;
        int wgid = (int)L; { const int q = nwg / NXCD, r = nwg % NXCD, xcd = wgid % NXCD, off = wgid / NXCD; wgid = (xcd < r ? xcd * (q + 1) : r * (q + 1) + (xcd - r) * q) + off; }
        const int nig = WGM * nN, gid = wgid / nig, fm = gid * WGM, gsz = (nM - fm) < WGM ? (nM - fm) : WGM;
        u.pm = fm + ((wgid % nig) % gsz); u.pn = (wgid % nig) / gsz; return true;
    }
    __device__ __forceinline__ void a_ready(const Unit&) const {}
    __device__ __forceinline__ void done(const Unit&) const {}
};

__device__ __forceinline__ unsigned cvt_pk_bf16(float lo, float hi) { unsigned r; asm volatile("v_cvt_pk_bf16_f32 %0, %1, %2" : "=v"(r) : "v"(lo), "v"(hi)); return r; }
typedef float f32x2 __attribute__((ext_vector_type(2)));
constexpr float RMS_EPS = 1e-6f;
typedef unsigned long long stat_t;
__device__ __forceinline__ float rstd_from(stat_t s) { const float f = __builtin_fmaf((float)(unsigned)(s >> 32), 4294967296.0f, (float)(unsigned)s); return __builtin_amdgcn_rsqf(f * (1.0f / (4294967296.0f * 1024.0f)) + RMS_EPS); }
__device__ __forceinline__ float rstd_of(const stat_t* st, int row) { return rstd_from(st[row]); }
__device__ __forceinline__ void stat_add(stat_t* st, int row, float ss) { atomicAdd(st + row, (stat_t)(ss * 4294967296.0f)); }
__device__ __forceinline__ float fast_sigmoid(float x) { return __builtin_amdgcn_rcpf(1.0f + __builtin_amdgcn_exp2f(-1.4426950408889634f * x)); }
typedef unsigned u32x4e __attribute__((ext_vector_type(4)));
__device__ __forceinline__ float bflo(unsigned w) { return __builtin_bit_cast(float, w << 16); }
__device__ __forceinline__ float bfhi(unsigned w) { return __builtin_bit_cast(float, w & 0xffff0000u); }

struct EpiSwiGLU {
    static constexpr bool PERM = true, AFTER_DRAIN = false;
    bf16_t* O; int ldc; const stat_t* st;
    __device__ __forceinline__ void operator()(const f32x4 (&acc)[2][2][4][2], const Unit& u, int wr, int wc, int fr, int fq) const {
        const int row0 = u.pm * BM + wr * 64 + fr, col0 = u.pn * HALF + wc * 32 + 8 * fq;
        stat_t sv[8];
#pragma unroll
        for (int i = 0; i < 8; ++i) sv[i] = st[row0 + (i >> 2) * HALF + (i & 3) * 16];
        asm volatile("" ::: "memory");
#pragma unroll
        for (int ai = 0; ai < 2; ++ai)
#pragma unroll
            for (int m = 0; m < 4; ++m) {
                const int row = row0 + ai * HALF + m * 16; const float r = rstd_from(sv[ai * 4 + m]);
                const float cr = -1.4426950408889634f * r, r2 = r * r; float o[8];
#pragma unroll
                for (int n = 0; n < 2; ++n)
#pragma unroll
                    for (int e = 0; e < 4; e += 2) { const f32x2 g2 = (f32x2){acc[ai][0][m][n][e], acc[ai][0][m][n][e + 1]}, u2 = (f32x2){acc[ai][1][m][n][e], acc[ai][1][m][n][e + 1]};
                        const f32x2 t = g2 * cr; f32x2 ex; ex.x = __builtin_amdgcn_exp2f(t.x); ex.y = __builtin_amdgcn_exp2f(t.y); const f32x2 d = ex + 1.0f;
                        f32x2 s; s.x = __builtin_amdgcn_rcpf(d.x); s.y = __builtin_amdgcn_rcpf(d.y); const f32x2 res = (g2 * u2) * (s * r2); o[n * 4 + e] = res.x; o[n * 4 + e + 1] = res.y; }
                u32x4e w; w.x = cvt_pk_bf16(o[0], o[1]); w.y = cvt_pk_bf16(o[2], o[3]); w.z = cvt_pk_bf16(o[4], o[5]); w.w = cvt_pk_bf16(o[6], o[7]);
                *(u32x4e*)(O + (size_t)row * ldc + col0) = w; }
    }
};
struct EpiRes {
    static constexpr bool PERM = true, AFTER_DRAIN = false;
    bf16_t* hb; stat_t* sto; float scale;
    __device__ __forceinline__ void operator()(const f32x4 (&acc)[2][2][4][2], const Unit& u, int wr, int wc, int fr, int fq) const {
        const int row0 = u.pm * BM + wr * 64 + fr, col0 = u.pn * BM + wc * 32 + 8 * fq;
#pragma unroll
        for (int ai = 0; ai < 2; ++ai) {
            u32x4e pre[4][2];
#pragma unroll
            for (int m = 0; m < 4; ++m)
#pragma unroll
                for (int bj = 0; bj < 2; ++bj) pre[m][bj] = *(const u32x4e*)(hb + (size_t)(row0 + ai * HALF + m * 16) * 1024 + col0 + bj * HALF);
            asm volatile("" ::: "memory");
#pragma unroll
            for (int m = 0; m < 4; ++m) {
                const int row = row0 + ai * HALF + m * 16; float ss = 0.f;
#pragma unroll
                for (int bj = 0; bj < 2; ++bj) {
                    const size_t off = (size_t)row * 1024 + col0 + bj * HALF;
                    const u32x4e bw = pre[m][bj];
                    const f32x4 b0 = (f32x4){bflo(bw.x), bfhi(bw.x), bflo(bw.y), bfhi(bw.y)}, b1 = (f32x4){bflo(bw.z), bfhi(bw.z), bflo(bw.w), bfhi(bw.w)};
                    const f32x4 v0 = b0 + acc[ai][bj][m][0] * scale, v1 = b1 + acc[ai][bj][m][1] * scale;
                    u32x4e w; w.x = cvt_pk_bf16(v0[0], v0[1]); w.y = cvt_pk_bf16(v0[2], v0[3]); w.z = cvt_pk_bf16(v1[0], v1[1]); w.w = cvt_pk_bf16(v1[2], v1[3]);
                    *(u32x4e*)(hb + off) = w;
                    ss += (v0[0] * v0[0] + v0[1] * v0[1]) + (v0[2] * v0[2] + v0[3] * v0[3]) + (v1[0] * v1[0] + v1[1] * v1[1]) + (v1[2] * v1[2] + v1[3] * v1[3]); }
                ss += __shfl_xor(ss, 16); ss += __shfl_xor(ss, 32);
                if (fq == 0) stat_add(sto, row, ss); } }
    }
};
struct EpiGluRes {
    static constexpr bool PERM = true, AFTER_DRAIN = false;
    bf16_t* hb; stat_t* sto;
    __device__ __forceinline__ void operator()(const f32x4 (&acc)[2][2][4][2], const Unit& u, int wr, int wc, int fr, int fq) const {
        const int row0 = u.pm * BM + wr * 64 + fr, col0 = u.pn * HALF + wc * 32 + 8 * fq;
        u32x4e pre[8];
#pragma unroll
        for (int i = 0; i < 8; ++i) pre[i] = *(const u32x4e*)(hb + (size_t)(row0 + (i >> 2) * HALF + (i & 3) * 16) * 1024 + col0);
        asm volatile("" ::: "memory");
#pragma unroll
        for (int ai = 0; ai < 2; ++ai)
#pragma unroll
            for (int m = 0; m < 4; ++m) {
                const int row = row0 + ai * HALF + m * 16; const size_t off = (size_t)row * 1024 + col0;
                const u32x4e bw = pre[ai * 4 + m];
                const f32x4 b0 = (f32x4){bflo(bw.x), bfhi(bw.x), bflo(bw.y), bfhi(bw.y)}, b1 = (f32x4){bflo(bw.z), bfhi(bw.z), bflo(bw.w), bfhi(bw.w)};
                f32x4 v0, v1;
#pragma unroll
                for (int e = 0; e < 4; ++e) { v0[e] = b0[e] + acc[ai][0][m][0][e] * fast_sigmoid(acc[ai][1][m][0][e]); v1[e] = b1[e] + acc[ai][0][m][1][e] * fast_sigmoid(acc[ai][1][m][1][e]); }
                u32x4e w; w.x = cvt_pk_bf16(v0[0], v0[1]); w.y = cvt_pk_bf16(v0[2], v0[3]); w.z = cvt_pk_bf16(v1[0], v1[1]); w.w = cvt_pk_bf16(v1[2], v1[3]);
                *(u32x4e*)(hb + off) = w;
                float ss = (v0[0] * v0[0] + v0[1] * v0[1]) + (v0[2] * v0[2] + v0[3] * v0[3]) + (v1[0] * v1[0] + v1[1] * v1[1]) + (v1[2] * v1[2] + v1[3] * v1[3]);
                ss += __shfl_xor(ss, 16); ss += __shfl_xor(ss, 32);
                if (fq == 0) stat_add(sto, row, ss); }
    }
};
template <bool KMEAN> struct EpiRowScale {
    static constexpr bool PERM = true, AFTER_DRAIN = false;
    bf16_t* O0; bf16_t* O1; const stat_t* st; float mul; float* kmp;
    __device__ __forceinline__ void operator()(const f32x4 (&acc)[2][2][4][2], const Unit& u, int wr, int wc, int fr, int fq) const {
        const int row0 = u.pm * BM + wr * 64 + fr, t = u.pn >> 2, col0 = (u.pn & 3) * BM + wc * 32 + 8 * fq;
        bf16_t* O = t ? O1 : O0;
        float cs[2][8];
#pragma unroll
        for (int bj = 0; bj < 2; ++bj)
#pragma unroll
            for (int j = 0; j < 8; ++j) cs[bj][j] = 0.f;
        stat_t sv[8];
#pragma unroll
        for (int i = 0; i < 8; ++i) sv[i] = st[row0 + (i >> 2) * HALF + (i & 3) * 16];
        asm volatile("" ::: "memory");
#pragma unroll
        for (int ai = 0; ai < 2; ++ai)
#pragma unroll
            for (int m = 0; m < 4; ++m) {
                const int row = row0 + ai * HALF + m * 16; const float r = rstd_from(sv[ai * 4 + m]) * mul;
#pragma unroll
                for (int bj = 0; bj < 2; ++bj) {
                    const f32x4 v0 = acc[ai][bj][m][0] * r, v1 = acc[ai][bj][m][1] * r;
                    u32x4e w; w.x = cvt_pk_bf16(v0[0], v0[1]); w.y = cvt_pk_bf16(v0[2], v0[3]); w.z = cvt_pk_bf16(v1[0], v1[1]); w.w = cvt_pk_bf16(v1[2], v1[3]);
                    *(u32x4e*)(O + (size_t)row * 1024 + col0 + bj * HALF) = w;
                    if (KMEAN) {
#pragma unroll
                        for (int e = 0; e < 4; ++e) { cs[bj][e] += v0[e]; cs[bj][4 + e] += v1[e]; } } } }
        if (KMEAN) {
            if (t == 0) {
#pragma unroll
                for (int bj = 0; bj < 2; ++bj)
#pragma unroll
                    for (int j = 0; j < 8; ++j) { float s = cs[bj][j]; s += __shfl_xor(s, 1); s += __shfl_xor(s, 2); s += __shfl_xor(s, 4); s += __shfl_xor(s, 8); cs[bj][j] = s; }
                if (fr == 0) {
#pragma unroll
                    for (int bj = 0; bj < 2; ++bj) { float* p = kmp + ((size_t)wr * 64 + u.pm) * 1024 + col0 + bj * HALF;
                        *(f32x4*)p = (f32x4){cs[bj][0], cs[bj][1], cs[bj][2], cs[bj][3]}; *(f32x4*)(p + 4) = (f32x4){cs[bj][4], cs[bj][5], cs[bj][6], cs[bj][7]}; } } } }
    }
};
template <class Epi, class Sched, bool ALIGN_EPI = false, bool SP2 = false>
__device__ __forceinline__ void gemm_phase(PG8_LAS unsigned char* lds, const Gemm g, const Sched& S, const Epi& E) {
    int tid_o = threadIdx.x; asm volatile("" : "+v"(tid_o));
    const int tid = tid_o, wid = __builtin_amdgcn_readfirstlane(tid >> 6), lane = tid & 63, wr = wid >> 2, wc = wid & 3, fr = lane & 15, fq = lane >> 4;
    const int K = g.K, nt = K / BK;
    unsigned voffA[2], voffB[2];
#pragma unroll
    for (int i = 0; i < 2; ++i) { int R, C; stage_rc(tid * 16 + i * 8192, R, C); const int Rb = Epi::PERM ? ((R & ~31) + perm32(R & 31)) : R;
        voffA[i] = (unsigned)(R * K + C) * 2u; voffB[i] = (unsigned)(Rb * K + C) * 2u; }
    const long ks0 = (long)(BK * 2);
    long kstep = ks0, nks = ks0;
    const size_t hstep = (size_t)HALF * K * 2;
    const size_t tstep = 2 * hstep;
    const unsigned ldsw = (unsigned)wid * 1024u;
    const int aoff = lds_byte(wr * 64 + fr, fq * 8), boff = lds_byte(wc * 32 + fr, fq * 8);
#define PG8_SA(b, h) (((b) * 2 + (h)) * HTB)
#define PG8_SB(b, h) ((4 + (b) * 2 + (h)) * HTB)
#define PG8_STAGE(bufoff, gbase, voff) do { _Pragma("unroll") for (int _i = 0; _i < 2; ++_i) \
        __builtin_amdgcn_global_load_lds((const unsigned*)((const char*)(gbase) + (voff)[_i]), (PG8_LAS unsigned*)(lds + (bufoff) + ldsw + _i * 8192), 16, 0, 0); } while (0)
#define PG8_LDA(dst, b, h) do { _Pragma("unroll") for (int m = 0; m < 4; ++m) _Pragma("unroll") for (int k = 0; k < 2; ++k) dst[m][k] = *(const PG8_LAS bf16x8*)(lds + PG8_SA(b, h) + aoff + m * 2048 + k * 1024); } while (0)
#define PG8_LDB(dst, b, h) do { _Pragma("unroll") for (int n = 0; n < 2; ++n) _Pragma("unroll") for (int k = 0; k < 2; ++k) dst[n][k] = *(const PG8_LAS bf16x8*)(lds + PG8_SB(b, h) + boff + n * 2048 + k * 1024); } while (0)
#define PG8_MMA(ai, bj, At, Bt) do { __builtin_amdgcn_s_setprio(1); _Pragma("unroll") for (int m = 0; m < 4; ++m) _Pragma("unroll") for (int n = 0; n < 2; ++n) _Pragma("unroll") for (int k = 0; k < 2; ++k) \
        acc[ai][bj][m][n] = __builtin_amdgcn_mfma_f32_16x16x32_bf16(Bt[n][k], At[m][k], acc[ai][bj][m][n], 0, 0, 0); __builtin_amdgcn_s_setprio(0); } while (0)
#define PG8_WAIT_V(n) asm volatile("s_waitcnt vmcnt(" #n ")" ::: "memory")
#define PG8_WAIT_L(n) asm volatile("s_waitcnt lgkmcnt(" #n ")" ::: "memory")
#define PG8_BAR __builtin_amdgcn_s_barrier()
#define PG8_SCHED __builtin_amdgcn_sched_barrier(0)
    Unit cur, nxt; int ui = 0;
    if (!S.next(0, cur)) return;
    f32x4 acc[2][2][4][2];
#pragma unroll
    for (int a = 0; a < 2; ++a)
#pragma unroll
        for (int b = 0; b < 2; ++b)
#pragma unroll
            for (int m = 0; m < 4; ++m)
#pragma unroll
                for (int n = 0; n < 2; ++n) acc[a][b][m][n] = (f32x4){0.f, 0.f, 0.f, 0.f};
    bf16x8 At[4][2], B0[2][2], B1[2][2];
    const char* cA = (const char*)g.A + (size_t)cur.pm * tstep; const char* cB = (const char*)g.Bt + (size_t)cur.pn * tstep;
    S.a_ready(cur);
    if constexpr (SP2) {
        PG8_STAGE(PG8_SB(0, 0), cB, voffB); PG8_STAGE(PG8_SB(0, 1), cB + hstep, voffB); PG8_STAGE(PG8_SA(0, 0), cA, voffA); PG8_STAGE(PG8_SA(0, 1), cA + hstep, voffA);
        if (wr == 1) PG8_BAR;
        PG8_WAIT_V(2); PG8_BAR;
        PG8_STAGE(PG8_SB(1, 0), cB + kstep, voffB); PG8_STAGE(PG8_SA(1, 0), cA + kstep, voffA); PG8_STAGE(PG8_SB(1, 1), cB + hstep + kstep, voffB);
        PG8_WAIT_V(6); PG8_BAR;
    } else {
        PG8_STAGE(PG8_SB(0, 0), cB, voffB); PG8_STAGE(PG8_SA(0, 0), cA, voffA); PG8_STAGE(PG8_SB(0, 1), cB + hstep, voffB); PG8_STAGE(PG8_SA(0, 1), cA + hstep, voffA);
        if (wr == 1) PG8_BAR;
        PG8_WAIT_V(4); PG8_BAR;
        PG8_STAGE(PG8_SB(1, 0), cB + kstep, voffB); PG8_STAGE(PG8_SA(1, 0), cA + kstep, voffA); PG8_STAGE(PG8_SB(1, 1), cB + hstep + kstep, voffB);
        PG8_WAIT_V(6); PG8_BAR;
    }
    for (;;) {
        const bool has_next = S.next(ui + 1, nxt);
        const bool ndn = has_next && (((ui + 1) & 1) != 0); const long noff = ndn ? (long)(nt - 1) * ks0 : 0; nks = has_next ? (ndn ? -ks0 : ks0) : kstep;
        const char* nA = has_next ? (const char*)g.A + (size_t)nxt.pm * tstep + noff : cA; const char* nB = has_next ? (const char*)g.Bt + (size_t)nxt.pn * tstep + noff : cB;
        for (int t = 0; t < nt; t += 2) {
            const bool last = (t == nt - 2);
            const char* a1 = cA + (long)(t + 1) * kstep;
            const char* a2 = last ? nA : cA + (long)(t + 2) * kstep; const char* b2 = last ? nB : cB + (long)(t + 2) * kstep;
            const char* a3 = a2 + (last ? nks : kstep); const char* b3 = b2 + (last ? nks : kstep);
            if (last && has_next) S.a_ready(nxt);
            if constexpr (SP2) {
            PG8_LDB(B0, 0, 0); PG8_LDB(B1, 0, 1); PG8_SCHED; PG8_LDA(At, 0, 0); PG8_STAGE(PG8_SA(1, 1), a1 + hstep, voffA);
            PG8_WAIT_V(8); PG8_WAIT_L(0); PG8_BAR; PG8_MMA(0, 0, At, B0); PG8_MMA(0, 1, At, B1); PG8_BAR; PG8_SCHED;
            PG8_LDA(At, 0, 1); PG8_STAGE(PG8_SB(0, 0), b2, voffB); PG8_STAGE(PG8_SB(0, 1), b2 + hstep, voffB); PG8_STAGE(PG8_SA(0, 0), a2, voffA);
            PG8_WAIT_V(8); PG8_WAIT_L(0); PG8_BAR; PG8_MMA(1, 0, At, B0); PG8_MMA(1, 1, At, B1); PG8_BAR; PG8_SCHED;
            PG8_LDB(B0, 1, 0); PG8_LDB(B1, 1, 1); PG8_SCHED; PG8_LDA(At, 1, 0); PG8_STAGE(PG8_SA(0, 1), a2 + hstep, voffA);
            PG8_WAIT_V(8); PG8_WAIT_L(0); PG8_BAR; PG8_MMA(0, 0, At, B0); PG8_MMA(0, 1, At, B1); PG8_BAR; PG8_SCHED;
            PG8_LDA(At, 1, 1); PG8_STAGE(PG8_SB(1, 0), b3, voffB); PG8_STAGE(PG8_SB(1, 1), b3 + hstep, voffB); PG8_STAGE(PG8_SA(1, 0), a3, voffA);
            PG8_WAIT_V(8); PG8_WAIT_L(0); PG8_BAR; PG8_MMA(1, 0, At, B0); PG8_MMA(1, 1, At, B1); PG8_BAR; PG8_SCHED;
            } else {
            PG8_LDB(B0, 0, 0); PG8_SCHED; PG8_LDA(At, 0, 0); PG8_STAGE(PG8_SA(1, 1), a1 + hstep, voffA);
            PG8_WAIT_L(8); PG8_BAR; PG8_WAIT_L(0); PG8_MMA(0, 0, At, B0); PG8_BAR; PG8_SCHED;
            PG8_LDB(B1, 0, 1); PG8_STAGE(PG8_SB(0, 0), b2, voffB);
            PG8_BAR; PG8_WAIT_L(0); PG8_MMA(0, 1, At, B1); PG8_BAR;
            PG8_LDA(At, 0, 1); PG8_STAGE(PG8_SA(0, 0), a2, voffA);
            PG8_BAR; PG8_WAIT_L(0); PG8_MMA(1, 0, At, B0); PG8_BAR; PG8_SCHED;
            PG8_STAGE(PG8_SB(0, 1), b2 + hstep, voffB);
            PG8_WAIT_V(6); PG8_BAR; PG8_MMA(1, 1, At, B1); PG8_BAR;
            PG8_LDB(B0, 1, 0); PG8_SCHED; PG8_LDA(At, 1, 0); PG8_STAGE(PG8_SA(0, 1), a2 + hstep, voffA);
            PG8_WAIT_L(8); PG8_BAR; PG8_WAIT_L(0); PG8_MMA(0, 0, At, B0); PG8_BAR; PG8_SCHED;
            PG8_LDB(B1, 1, 1); PG8_STAGE(PG8_SB(1, 0), b3, voffB);
            PG8_BAR; PG8_WAIT_L(0); PG8_MMA(0, 1, At, B1); PG8_BAR;
            PG8_LDA(At, 1, 1); PG8_STAGE(PG8_SA(1, 0), a3, voffA);
            PG8_BAR; PG8_WAIT_L(0); PG8_MMA(1, 0, At, B0); PG8_BAR; PG8_SCHED;
            PG8_STAGE(PG8_SB(1, 1), b3 + hstep, voffB);
            PG8_WAIT_V(6); PG8_BAR; PG8_MMA(1, 1, At, B1); PG8_BAR;
            }
        }
        if constexpr (ALIGN_EPI) { if (wr == 0) PG8_BAR; }
        if constexpr (!Epi::AFTER_DRAIN) { E(acc, cur, wr, wc, fr, fq); S.done(cur); }
        if (!has_next) break;
#pragma unroll
        for (int a = 0; a < 2; ++a)
#pragma unroll
            for (int b = 0; b < 2; ++b)
#pragma unroll
                for (int m = 0; m < 4; ++m)
#pragma unroll
                    for (int n = 0; n < 2; ++n) acc[a][b][m][n] = (f32x4){0.f, 0.f, 0.f, 0.f};
        cur = nxt; cA = nA; cB = nB; kstep = nks; ++ui;
        if constexpr (ALIGN_EPI) { if (wr == 1) PG8_BAR; }
    }
    PG8_WAIT_V(0);
    if constexpr (!ALIGN_EPI) { if (wr == 0) PG8_BAR; }
    PG8_BAR;
    if constexpr (Epi::AFTER_DRAIN) { E.fused(acc, cur, wr, wc, fr, fq, lds, wid, lane); S.done(cur); }
#undef PG8_SA
#undef PG8_SB
#undef PG8_STAGE
#undef PG8_LDA
#undef PG8_LDB
#undef PG8_MMA
#undef PG8_WAIT_V
#undef PG8_WAIT_L
#undef PG8_BAR
#undef PG8_SCHED
}
}

constexpr int NWAVES = 8, NTHR = NWAVES * 64;
constexpr int BATCH = 8, SEQ = 2048, DM = 1024, DEPTH = 4, NA = 2, NBL = 2, SG = 64, SGC = 16, SP = 64, NH = 16, HD = 64, MBLK = 256, NBLK = SEQ / MBLK, DFF = 2816;
constexpr int M = BATCH * SEQ;
constexpr float C2 = 0.125f * 1.4426950408889634f;
constexpr size_t MiB = 1u << 20;
constexpr size_t WS_CTL = 0, CTL_ZERO_BYTES = 3 * MiB;
constexpr size_t WS_STATS = 1 * MiB;
constexpr size_t WS_L16 = 3 * MiB + 512 * 1024, WS_DG = WS_L16 + 64 * 1024;
constexpr size_t WS_KMP = 3 * MiB;
constexpr size_t WS_WIN = 4 * MiB, WIN_BYTES = (size_t)2 * DFF * DM * 2;
constexpr size_t WS_WOUT = WS_WIN + 8 * WIN_BYTES, WOUT_BYTES = (size_t)DM * DFF * 2;
constexpr size_t WS_WGLU = WS_WOUT + 8 * WOUT_BYTES, WGLU_BYTES = (size_t)2 * DM * DM * 2;
constexpr size_t WS_WKV = WS_WGLU + 2 * WGLU_BYTES;
constexpr size_t WS_WQ = WS_WKV + 4 * MiB, WS_WO = WS_WQ + 4 * MiB;
constexpr size_t WS_HB = WS_WO + 4 * MiB;
constexpr size_t WS_ACT = WS_HB + 32 * MiB;
constexpr size_t WS_K = WS_ACT + 88 * MiB, WS_V = WS_K + 32 * MiB, WS_END = WS_V + 32 * MiB;
static_assert(WS_WIN + 8 * WIN_BYTES + 8 * WOUT_BYTES + 2 * WGLU_BYTES + 12 * MiB == WS_HB && WS_HB == 156 * MiB && WS_END == 340 * MiB, "d_ws map");
constexpr int CW_TMO = 0, CW_BAR = 4096;
constexpr int NPHASE = 28;
constexpr int RING_OFF = 0, RING_BYTES = 131072;
constexpr int LDSCTL_OFF = RING_BYTES, MISC_OFF = LDSCTL_OFF + 320;
constexpr int LDS_BYTES = 147456;
#define GAS __attribute__((address_space(1)))
#define LAS __attribute__((address_space(3)))
typedef unsigned short bf16;
typedef unsigned v4u __attribute__((ext_vector_type(4)));
typedef float f32x4 __attribute__((ext_vector_type(4)));
typedef short bf16x8 __attribute__((ext_vector_type(8)));
typedef GAS unsigned gu32;
typedef GAS unsigned long long gu64;
#define RLX_AGENT __ATOMIC_RELAXED, __HIP_MEMORY_SCOPE_AGENT
#define LDS_WAIT() asm volatile("s_waitcnt lgkmcnt(0)" ::: "memory")
#define VM_WAIT() asm volatile("s_waitcnt vmcnt(0)" ::: "memory")
__device__ __forceinline__ unsigned long long rt() { return __builtin_amdgcn_s_memrealtime(); }
__device__ __forceinline__ unsigned f2bf(float f) { unsigned u = __builtin_bit_cast(unsigned, f); return (u + 0x7fffu + ((u >> 16) & 1u)) >> 16; }
__device__ __forceinline__ unsigned pk2(float lo, float hi) { return f2bf(lo) | (f2bf(hi) << 16); }

#define XB_TMO      128
#define XB_XCNT(j)  (256  + 64 * (j))
#define XB_XSUB(j)  (1280 + 64 * (j))
#define XB_XGEN(j)  (2304 + 64 * (j))
#define XB_TOP      3328
#define XB_TOPGEN   3392
#define XCD_BAR_WORDS 3456
#define XB_SPIN_CAP (1u << 18)

__device__ __forceinline__ unsigned xb_ld(unsigned* p)              { return __hip_atomic_load(p, __ATOMIC_RELAXED, __HIP_MEMORY_SCOPE_AGENT); }
__device__ __forceinline__ unsigned xb_add(unsigned* p, unsigned v) { return __hip_atomic_fetch_add(p, v, __ATOMIC_RELAXED, __HIP_MEMORY_SCOPE_AGENT); }
__device__ __forceinline__ unsigned xb_xcc_id() { return (unsigned)__builtin_amdgcn_s_getreg((3 << 11) | 20) & 0xFu; }
#define XB_SPIN(cond, bar) do { unsigned _sp = 0; while (cond) { __builtin_amdgcn_s_sleep(1); \
    if ((++_sp & 255u) == 0u) { if (xb_ld(&(bar)[XB_TMO])) break; if (_sp > XB_SPIN_CAP) { atomicAdd(&(bar)[XB_TMO], 1u); break; } } } } while (0)

struct XcdBarrier {
    unsigned* bar; unsigned x;
    volatile LAS unsigned* st;
};

__device__ __forceinline__ XcdBarrier xcd_barrier_post(unsigned* bar, volatile LAS unsigned* st) {
    XcdBarrier b; b.bar = bar; b.x = xb_xcc_id(); b.st = st;
    if (threadIdx.x == 0) (void)xb_add(&bar[XB_XCNT(b.x)], 1u);
    return b;
}
__device__ __forceinline__ void xcd_barrier_complete(unsigned* bar, unsigned x, unsigned& nloc, unsigned& nx) {
    const unsigned G = gridDim.x * gridDim.y * gridDim.z;
    unsigned sum, cnt, mine, sp = 0u;
    for (;;) {
        sum = 0u; cnt = 0u; mine = 0u;
#pragma unroll
        for (unsigned j = 0; j < 16; ++j) { const unsigned c = xb_ld(&bar[XB_XCNT(j)]); sum += c; cnt += (c > 0u) ? 1u : 0u; mine = (j == x) ? c : mine; }
        if (sum == G) break;
        __builtin_amdgcn_s_sleep(1);
        if ((++sp & 255u) == 0u) { if (xb_ld(&bar[XB_TMO])) break; if (sp > XB_SPIN_CAP) { atomicAdd(&bar[XB_TMO], 1u); break; } }
    }
    nloc = mine > 0u ? mine : 1u; nx = cnt > 0u ? cnt : 1u;
}

__device__ __forceinline__ void xcd_barrier(const XcdBarrier& b) {
    asm volatile("s_waitcnt vmcnt(0)" ::: "memory");
    __syncthreads();
    if (threadIdx.x == 0) {
        unsigned* bar = b.bar;
        __builtin_amdgcn_s_waitcnt(0);
        unsigned nloc = b.st[0], nx = b.st[1];
        if (nloc == 0u) { xcd_barrier_complete(bar, b.x, nloc, nx); b.st[0] = nloc; b.st[1] = nx; }
        const unsigned old = xb_add(&bar[XB_XSUB(b.x)], 1u);
        const unsigned gen = old / nloc;
        if (old + 1u == (gen + 1u) * nloc) {
            __builtin_amdgcn_fence(__ATOMIC_RELEASE, "agent");
            asm volatile("s_waitcnt vmcnt(0)" ::: "memory");
            const unsigned og = xb_add(&bar[XB_TOP], 1u);
            const unsigned tg = og / nx;
            if (og + 1u == (tg + 1u) * nx) xb_add(&bar[XB_TOPGEN], 1u);
            else XB_SPIN(xb_ld(&bar[XB_TOPGEN]) == tg, bar);
            __builtin_amdgcn_fence(__ATOMIC_ACQUIRE, "agent");
            xb_add(&bar[XB_XGEN(b.x)], 1u);
            asm volatile("s_waitcnt vmcnt(0)" ::: "memory");
        } else {
            XB_SPIN(xb_ld(&bar[XB_XGEN(b.x)]) == gen, bar);
            __builtin_amdgcn_fence(__ATOMIC_ACQUIRE, "agent");
            asm volatile("s_waitcnt vmcnt(0)" ::: "memory");
        }
    }
    __syncthreads();
}

typedef unsigned v2u __attribute__((ext_vector_type(2)));
__device__ __forceinline__ float bf_lo(unsigned w) { return __builtin_bit_cast(float, w << 16); }
__device__ __forceinline__ float bf_hi(unsigned w) { return __builtin_bit_cast(float, w & 0xffff0000u); }
__device__ __forceinline__ float wave_sum(float v) {
#pragma unroll
    for (int o = 1; o < 64; o <<= 1) v += __shfl_xor(v, o);
    return v;
}
__device__ __forceinline__ void p0_transpose_item(const float* W, int ldw, int srccol0, const float* gain, bf16* WT, int K, int n0, int k0, LAS float* scr, int lane) {
    { const int kr = lane >> 3, c4 = (lane & 7) * 4; f32x4 v[8]; float gv[8];
#pragma unroll
      for (int i = 0; i < 8; ++i) { const int kk = kr + 8 * i; v[i] = *(const f32x4*)(W + (size_t)(k0 + kk) * ldw + srccol0 + c4); gv[i] = gain ? gain[k0 + kk] : 1.0f; }
#pragma unroll
      for (int i = 0; i < 8; ++i) { const int kk = kr + 8 * i; LAS float* d = scr + kk * 33 + c4; const f32x4 w = v[i] * gv[i]; d[0] = w.x; d[1] = w.y; d[2] = w.z; d[3] = w.w; } }
    LDS_WAIT(); asm volatile("" ::: "memory");
    const int c = lane & 7;
#pragma unroll
    for (int j = 0; j < 4; ++j) { const int n = (lane >> 3) + 8 * j; const LAS float* s = scr + (8 * c) * 33 + n;
        v4u o; o.x = pk2(s[0 * 33], s[1 * 33]); o.y = pk2(s[2 * 33], s[3 * 33]); o.z = pk2(s[4 * 33], s[5 * 33]); o.w = pk2(s[6 * 33], s[7 * 33]);
        *(v4u*)(WT + (size_t)(n0 + n) * K + k0 + 8 * c) = o; }
    LDS_WAIT(); asm volatile("" ::: "memory");
}
__device__ __forceinline__ int il_col(int n0, int Hn) { const int t = n0 >> 8, w = n0 & 255; return (w < 128) ? t * 128 + w : Hn + t * 128 + (w - 128); }

struct Args { const float* in[22]; float* out; unsigned char* ws; int ph_lo, ph_hi; };
__device__ __forceinline__ float gelu_tanh(float x) { const float t = 0.7978845608028654f * (x + 0.044715f * x * x * x); return x * __builtin_amdgcn_rcpf(1.0f + __builtin_amdgcn_exp2f(-2.0f * 1.4426950408889634f * t)); }
__device__ __forceinline__ float fma_asm(float a, float b, float c) { float d; asm("v_fma_f32 %0, %1, %2, %3" : "=v"(d) : "v"(a), "v"(b), "v"(c)); return d; }
__device__ __forceinline__ void sincos_f(float ang, float& s, float& c) {
    const float q = __builtin_rintf(ang * 0.63661977236758134308f);
    float r = __builtin_fmaf(-q, 1.5707855225e+00f, ang); r = __builtin_fmaf(-q, 1.0804334124e-05f, r); const float r2 = r * r;
    float sp = fma_asm(2.7557319223985893e-06f, r2, -1.9841269841269841e-04f); sp = fma_asm(sp, r2, 8.3333333333333332e-03f); sp = fma_asm(sp, r2, -1.6666666666666666e-01f); const float sr = fma_asm(r * r2, sp, r);
    float cp = fma_asm(2.4801587301587302e-05f, r2, -1.3888888888888889e-03f); cp = fma_asm(cp, r2, 4.1666666666666664e-02f); cp = fma_asm(cp, r2, -0.5f); const float cr = fma_asm(r2, cp, 1.0f);
    const int qi = ((int)q) & 3;
    s = (qi == 0) ? sr : (qi == 1) ? cr : (qi == 2) ? -sr : -cr; c = (qi == 0) ? cr : (qi == 1) ? -sr : (qi == 2) ? -cr : sr;
}
template <class T> __device__ __forceinline__ T* opq(T* p) { size_t z = 0; asm volatile("" : "+s"(z)); return (T*)((unsigned char*)p + z); }
namespace s5 {
typedef float f32x16 __attribute__((ext_vector_type(16)));
typedef short bf16x8s __attribute__((ext_vector_type(8)));
constexpr int UP = 264, XP = 136;
constexpr int LDS_U = 0, LDS_X = 128 * UP * 2, LDS_E = LDS_X + 128 * XP * 2, LDS_END = LDS_E + 4 * 64 * 8;
constexpr size_t MAT_ELEMS = 131072, CM_OFF = 32768;
__device__ __forceinline__ int crow(int r, int hi) { return (r & 3) + 8 * (r >> 2) + 4 * hi; }
__device__ __forceinline__ float partner(float v, int hi) { auto rr = __builtin_amdgcn_permlane32_swap(__float_as_uint(v), __float_as_uint(v), false, false); return __uint_as_float(hi ? rr[0] : rr[1]); }
template <bool STORE> __device__ __forceinline__ void scan_rg(float& xr, float& xi, const float l16r, const float l16i, const f32x16& sre, const f32x16& sim, const int rg, const int hi, LAS unsigned short* xrow  ) {
    float ar = xr, ai = xi, par[4], pai[4];
#pragma unroll
    for (int i = 0; i < 4; ++i) { par[i] = ar; pai[i] = ai; const float nr = l16r * ar - l16i * ai + sre[4 * rg + i], ni = l16r * ai + l16i * ar + sim[4 * rg + i]; ar = nr; ai = ni; }
    float br = partner(ar, hi), bi = partner(ai, hi), pbr[4], pbi[4];
#pragma unroll
    for (int i = 0; i < 4; ++i) { pbr[i] = br; pbi[i] = bi; const float nr = l16r * br - l16i * bi + sre[4 * rg + i], ni = l16r * bi + l16i * br + sim[4 * rg + i]; br = nr; bi = ni; }
    if (STORE) {
#pragma unroll
        for (int i = 0; i < 4; ++i) { const float vr = hi ? pbr[i] : par[i], vi = hi ? pbi[i] : pai[i]; xrow[i * XP] = (unsigned short)f2bf(vr); xrow[i * XP + 64] = (unsigned short)f2bf(vi); } }
    const float or_ = partner(br, hi), oi_ = partner(bi, hi);
    xr = hi ? br : or_; xi = hi ? bi : oi_;
}
template <int VAR> __device__ __forceinline__ void phase_s5(const Args& a, LAS unsigned char* lds, int layer, const pg8::stat_t* stats, int G) {
    int tid_o = threadIdx.x; asm volatile("" : "+v"(tid_o)); const int tid = tid_o, lane = tid & 63, wave = __builtin_amdgcn_readfirstlane(tid >> 6), r32 = lane & 31, hi = lane >> 5;
    unsigned char* ws = opq(a.ws);
    const bf16* mats = (const bf16*)(ws + WS_K) + (size_t)layer * SG * MAT_ELEMS;
    const float* L16 = (const float*)(ws + WS_L16) + layer * SG * SP * 2; const float* DG = (const float*)(ws + WS_DG) + layer * DM;
    const bf16* hbp = (const bf16*)(ws + WS_HB); bf16* z = (bf16*)(ws + WS_ACT);
    LAS unsigned short* U = (LAS unsigned short*)(lds + LDS_U); LAS unsigned short* X = (LAS unsigned short*)(lds + LDS_X); LAS float* EX = (LAS float*)(lds + LDS_E);
    for (int u = blockIdx.x; u < BATCH * SG; u += G) {
        int b = u >> 6, g = u & 63;
        if (G == 256) { const int c = u & 255, w = (u >> 8) * 32 + (c >> 3); g = (c & 7) * 8 + (w & 7); b = w >> 3; }
        const bf16* BC = mats + (size_t)g * MAT_ELEMS; const bf16* CM = BC + CM_OFF;
        { v4u hw[8]; pg8::stat_t sv[8];
#pragma unroll
          for (int i = 0; i < 8; ++i) { const int idx = i * NTHR + tid, t = idx >> 1, j8 = (idx & 1) * 8; const int row = b * SEQ + t; hw[i] = *(const v4u*)(hbp + (size_t)row * DM + g * SGC + j8); sv[i] = stats[row]; }
#pragma unroll
          for (int i = 0; i < 8; ++i) { const int idx = i * NTHR + tid, t = idx >> 1, j8 = (idx & 1) * 8; const float r = pg8::rstd_from(sv[i]); v4u w;
            w.x = pk2(bf_lo(hw[i].x) * r, bf_hi(hw[i].x) * r); w.y = pk2(bf_lo(hw[i].y) * r, bf_hi(hw[i].y) * r); w.z = pk2(bf_lo(hw[i].z) * r, bf_hi(hw[i].z) * r); w.w = pk2(bf_lo(hw[i].w) * r, bf_hi(hw[i].w) * r);
            *(LAS v4u*)(U + (t >> 4) * UP + (t & 15) * 16 + j8) = w; } }
        const int st = wave & 1, q = wave >> 1; f32x16 sre, sim;
#pragma unroll
        for (int r = 0; r < 16; ++r) { sre[r] = 0.f; sim[r] = 0.f; }
        { const bf16* bcr = BC + (size_t)(32 * st + r32) * 256 + 8 * hi; const bf16* bci = bcr + 64 * 256; const LAS unsigned short* ua = U + (32 * q + r32) * UP + 8 * hi;
          bf16x8s b0[16], b1[16];
#pragma unroll
          for (int ks = 0; ks < 16; ++ks) { b0[ks] = *(const bf16x8s*)(bcr + 16 * ks); b1[ks] = *(const bf16x8s*)(bci + 16 * ks); }
          __syncthreads();
#pragma unroll
          for (int ks = 0; ks < 16; ++ks) { const bf16x8s av = *(const LAS bf16x8s*)(ua + 16 * ks);
              sre = __builtin_amdgcn_mfma_f32_32x32x16_bf16(av, b0[ks], sre, 0, 0, 0); sim = __builtin_amdgcn_mfma_f32_32x32x16_bf16(av, b1[ks], sim, 0, 0, 0); } }
        const int Rs = wave < 4 ? wave : 7 - wave, Rl = 7 - Rs, atS = wave < 4 ? 0 : 2, atL = 2 - atS;
        const bf16* cmS = CM + (size_t)(32 * Rs + r32) * 384 + 8 * hi; const bf16* cmL = CM + (size_t)(32 * Rl + r32) * 384 + 8 * hi;
        bf16x8s cfS[16];
#pragma unroll
        for (int ks = 0; ks < 16; ++ks) cfS[ks] = *(const bf16x8s*)(cmS + 16 * ks);
        const f32x4 dg0 = *(const f32x4*)(DG + g * SGC + 4 * hi), dg1 = *(const f32x4*)(DG + g * SGC + 8 + 4 * hi);
        const int p = 32 * st + r32; const float l16r = L16[(g * SP + p) * 2], l16i = L16[(g * SP + p) * 2 + 1];
        float xr = 0.f, xi = 0.f;
#pragma unroll
        for (int rg = 0; rg < 4; ++rg) scan_rg<false>(xr, xi, l16r, l16i, sre, sim, rg, hi, nullptr);
        if (hi == 0) { EX[(q * 64 + p) * 2] = xr; EX[(q * 64 + p) * 2 + 1] = xi; }
        float Lr = l16r, Li = l16i;
#pragma unroll
        for (int s = 0; s < 5; ++s) { const float nr = Lr * Lr - Li * Li, ni = 2.0f * Lr * Li; Lr = nr; Li = ni; }
        __syncthreads();
        xr = 0.f; xi = 0.f;
        for (int qq = 0; qq < q; ++qq) { const float er = EX[(qq * 64 + p) * 2], ei = EX[(qq * 64 + p) * 2 + 1]; const float nr = Lr * xr - Li * xi + er, ni = Lr * xi + Li * xr + ei; xr = nr; xi = ni; }
#pragma unroll
        for (int rg = 0; rg < 4; ++rg) scan_rg<true>(xr, xi, l16r, l16i, sre, sim, rg, hi, X + (32 * q + crow(4 * rg, hi)) * XP + p);
        __syncthreads();
#define S5_JOB(R, at, NF, cf) do { f32x16 acc0, acc1; \
            _Pragma("unroll") for (int r = 0; r < 16; ++r) { acc0[r] = 0.f; acc1[r] = 0.f; } \
            const LAS unsigned short* xa = X + (32 * (at) + r32) * XP + 8 * hi; const LAS unsigned short* ua = U + (32 * (at) + r32) * UP + 8 * hi; \
            _Pragma("unroll") for (int ks = 0; ks < 8; ++ks) { const bf16x8s x0 = *(const LAS bf16x8s*)(xa + 16 * ks), x1 = *(const LAS bf16x8s*)(xa + 32 * XP + 16 * ks); \
                acc0 = __builtin_amdgcn_mfma_f32_32x32x16_bf16(cf[ks], x0, acc0, 0, 0, 0); acc1 = __builtin_amdgcn_mfma_f32_32x32x16_bf16(cf[ks], x1, acc1, 0, 0, 0); } \
            _Pragma("unroll") for (int sg = 0; sg < (NF) - 8; ++sg) { const bf16x8s u0 = *(const LAS bf16x8s*)(ua + 16 * sg), u1 = *(const LAS bf16x8s*)(ua + 32 * UP + 16 * sg); \
                acc0 = __builtin_amdgcn_mfma_f32_32x32x16_bf16(cf[8 + sg], u0, acc0, 0, 0, 0); acc1 = __builtin_amdgcn_mfma_f32_32x32x16_bf16(cf[8 + sg], u1, acc1, 0, 0, 0); } \
            _Pragma("unroll") for (int rt = 0; rt < 2; ++rt) { const int chunk = 32 * ((at) + rt) + r32; \
                _Pragma("unroll") for (int q4 = 0; q4 < 4; ++q4) { const int tau = 2 * (R) + (q4 >> 1), j0 = (q4 & 1) * 8 + 4 * hi; \
                    const v2u uw = *(const LAS v2u*)(U + chunk * UP + tau * 16 + j0); const f32x4 dg = (q4 & 1) ? dg1 : dg0; \
                    const float y0 = (rt ? acc1[4 * q4] : acc0[4 * q4]) + dg.x * bf_lo(uw.x), y1 = (rt ? acc1[4 * q4 + 1] : acc0[4 * q4 + 1]) + dg.y * bf_hi(uw.x); \
                    const float y2 = (rt ? acc1[4 * q4 + 2] : acc0[4 * q4 + 2]) + dg.z * bf_lo(uw.y), y3 = (rt ? acc1[4 * q4 + 3] : acc0[4 * q4 + 3]) + dg.w * bf_hi(uw.y); \
                    v2u zw; zw.x = pk2(gelu_tanh(y0), gelu_tanh(y1)); zw.y = pk2(gelu_tanh(y2), gelu_tanh(y3)); \
                    *(v2u*)(z + ((size_t)b * SEQ + 16 * chunk + tau) * DM + g * SGC + j0) = zw; } } } while (0)
        { bf16x8s cfL[24];
#pragma unroll
          for (int ks = 0; ks < 24; ++ks) cfL[ks] = *(const bf16x8s*)(cmL + 16 * ks);
          S5_JOB(Rs, atS, 16, cfS);
          S5_JOB(Rl, atL, 24, cfL); }
#undef S5_JOB
        __syncthreads();
    }
}
__device__ __forceinline__ void s5_gen_item(const Args& a, LAS unsigned char* lds, int item) {
    int tid_o = threadIdx.x; asm volatile("" : "+v"(tid_o)); const int tid = tid_o;
    const int layer = item >> 7, g = (item >> 1) & 63, half = item & 1, lg = layer * SG + g;
    unsigned char* ws = opq(a.ws);
    LAS float* pw = (LAS float*)lds; LAS float* bb = pw + 17 * 128; LAS float* cc = bb + 2048; LAS float* kl = cc + 2048; LAS float* fz = kl + 4096;
    bf16* BC = (bf16*)(ws + WS_K) + ((size_t)layer * SG + g) * MAT_ELEMS; bf16* CM = BC + CM_OFF;
    if (tid < 64) { const int p = tid; const float dt = expf(a.in[15][lg]); const float ar = fminf(a.in[8][lg * SP + p], -1e-4f), ai = a.in[9][lg * SP + p];
        const float mag = expf(ar * dt); float sn, cn; sincos_f(ai * dt, sn, cn);
        const double dlr = (double)(mag * cn), dli = (double)(mag * sn), nr = dlr - 1.0, dar = (double)ar, dai = (double)ai, den = dar * dar + dai * dai;
        fz[2 * p] = (float)((nr * dar + dli * dai) / den); fz[2 * p + 1] = (float)((dli * dar - nr * dai) / den);
        double wr = 1.0, wi = 0.0;
        for (int k = 0; k <= 16; ++k) { pw[(k * 64 + p) * 2] = (float)wr; pw[(k * 64 + p) * 2 + 1] = (float)wi; const double t = wr * dlr - wi * dli; wi = wr * dli + wi * dlr; wr = t; }
    }
    __syncthreads();
    { const float* gain = a.in[4] + layer * DM + g * SGC;
      for (int i = tid; i < 1024; i += NTHR) { const int p = i >> 4, j = i & 15; const float fr = fz[2 * p], fi = fz[2 * p + 1]; const float br = a.in[10][((size_t)lg * SP + p) * SGC + j], bi = a.in[11][((size_t)lg * SP + p) * SGC + j], gn = gain[j];
          bb[i * 2] = (fr * br - fi * bi) * gn; bb[i * 2 + 1] = (fr * bi + fi * br) * gn; }
      for (int i = tid; i < 1024; i += NTHR) { cc[i * 2] = a.in[12][(size_t)lg * 1024 + i]; cc[i * 2 + 1] = a.in[13][(size_t)lg * 1024 + i]; }
      if (half == 0) { if (tid < 64) { float* L16 = (float*)(ws + WS_L16) + (size_t)lg * SP * 2; L16[2 * tid] = pw[(16 * 64 + tid) * 2]; L16[2 * tid + 1] = pw[(16 * 64 + tid) * 2 + 1]; }
          if (tid >= 64 && tid < 80) { const int j = tid - 64; ((float*)(ws + WS_DG))[layer * DM + g * SGC + j] = a.in[14][layer * DM + g * SGC + j] * gain[j]; } } }
    __syncthreads();
    { const int lag = tid >> 5, j = (tid >> 1) & 15, jh = (tid & 1) * 8; float acc[8];
#pragma unroll
      for (int i = 0; i < 8; ++i) acc[i] = 0.f;
      for (int p = 0; p < 64; ++p) { const float cr = cc[(j * 64 + p) * 2], ci = cc[(j * 64 + p) * 2 + 1], wr = pw[(lag * 64 + p) * 2], wi = pw[(lag * 64 + p) * 2 + 1]; const float tr = cr * wr - ci * wi, ti = cr * wi + ci * wr;
#pragma unroll
          for (int i = 0; i < 8; ++i) acc[i] += tr * bb[((p * 16) + jh + i) * 2] - ti * bb[((p * 16) + jh + i) * 2 + 1]; }
#pragma unroll
      for (int i = 0; i < 8; ++i) kl[(lag * 16 + j) * 16 + jh + i] = acc[i]; }
    __syncthreads();
    if (half == 0) {
        for (int ci = tid; ci < 4096; ci += NTHR) { const int s = ci >> 5, k0 = (ci & 31) * 8, sig = k0 >> 4, j0 = k0 & 15, p = s & 63, im = s >> 6; const float wr = pw[((15 - sig) * 64 + p) * 2], wi = pw[((15 - sig) * 64 + p) * 2 + 1]; float v[8];
#pragma unroll
            for (int e = 0; e < 8; ++e) { const float br = bb[(p * 16 + j0 + e) * 2], bi = bb[(p * 16 + j0 + e) * 2 + 1]; v[e] = im ? (wr * bi + wi * br) : (wr * br - wi * bi); }
            v4u o; o.x = pk2(v[0], v[1]); o.y = pk2(v[2], v[3]); o.z = pk2(v[4], v[5]); o.w = pk2(v[6], v[7]); *(v4u*)(BC + (size_t)s * 256 + k0) = o; } }
    for (int ci = tid; ci < 6144; ci += NTHR) { const int rl = ci / 48, k0 = (ci % 48) * 8, row = half * 128 + rl, tau = row >> 4, j = row & 15; float v[8];
        if (k0 < 128) { const int im = k0 >> 6, p0 = k0 & 63;
#pragma unroll
            for (int e = 0; e < 8; ++e) { const int p = p0 + e; const float cr = cc[(j * 64 + p) * 2], ci2 = cc[(j * 64 + p) * 2 + 1], wr = pw[((tau + 1) * 64 + p) * 2], wi = pw[((tau + 1) * 64 + p) * 2 + 1]; v[e] = im ? -(cr * wi + ci2 * wr) : (cr * wr - ci2 * wi); } }
        else { const int sig = (k0 - 128) >> 4, j0 = (k0 - 128) & 15; const int lag = tau - sig;
#pragma unroll
            for (int e = 0; e < 8; ++e) v[e] = (lag >= 0) ? kl[((lag < 0 ? 0 : lag) * 16 + j) * 16 + j0 + e] : 0.f; }
        v4u o; o.x = pk2(v[0], v[1]); o.y = pk2(v[2], v[3]); o.z = pk2(v[4], v[5]); o.w = pk2(v[6], v[7]); *(v4u*)(CM + (size_t)row * 384 + k0) = o; }
    __syncthreads();
}
}

constexpr int I_IN = (DM / 64) * (2 * DFF / 32), I_OUT = (DFF / 64) * (DM / 32), I_GLU = (DM / 64) * (2 * DM / 32), I_KV = I_GLU, I_SQ = (DM / 64) * (DM / 32);
constexpr int T_IN = 8 * I_IN, T_OUT = 8 * I_OUT, T_GLU = 2 * I_GLU, T_KV = I_KV, T_Q = 2 * I_SQ, T_O = 2 * I_SQ, NITEMS = T_IN + T_OUT + T_GLU + T_KV + T_Q + T_O;
constexpr int IT_OUT = T_IN, IT_GLU = IT_OUT + T_OUT, IT_KV = IT_GLU + T_GLU, IT_Q = IT_KV + T_KV, IT_O = IT_Q + T_Q;
__device__ __forceinline__ void convert_item(const Args& a, unsigned char* ws, int it, LAS float* scr, int lane) {
    int r = it;
    if (r < T_IN) { const int j = r / I_IN, q = r % I_IN, l = j >> 1, f = j & 1; const int nblk = 2 * DFF / 32, kb = q / nblk, nb = q % nblk, n0 = 32 * nb;
        p0_transpose_item(a.in[f ? 6 : 2] + (size_t)l * DM * 2 * DFF, 2 * DFF, il_col(n0, DFF), a.in[f ? 5 : 1] + l * DM, (bf16*)(ws + WS_WIN + (size_t)j * WIN_BYTES), DM, n0, 64 * kb, scr, lane); return; } r -= T_IN;
    if (r < T_OUT) { const int j = r / I_OUT, q = r % I_OUT, l = j >> 1, f = j & 1; const int nblk = DM / 32, kb = q / nblk, nb = q % nblk, n0 = 32 * nb;
        p0_transpose_item(a.in[f ? 7 : 3] + (size_t)l * DFF * DM, DM, n0, nullptr, (bf16*)(ws + WS_WOUT + (size_t)j * WOUT_BYTES), DFF, n0, 64 * kb, scr, lane); return; } r -= T_OUT;
    if (r < T_GLU) { const int l = r / I_GLU, q = r % I_GLU; const int nblk = 2 * DM / 32, kb = q / nblk, nb = q % nblk, n0 = 32 * nb;
        p0_transpose_item(a.in[16] + (size_t)l * DM * 2 * DM, 2 * DM, il_col(n0, DM), nullptr, (bf16*)(ws + WS_WGLU + (size_t)l * WGLU_BYTES), DM, n0, 64 * kb, scr, lane); return; } r -= T_GLU;
    if (r < T_KV) { const int q = r; const int nblk = 2 * DM / 32, kb = q / nblk, nb = q % nblk, n0 = 32 * nb;
        p0_transpose_item(a.in[18], 2 * DM, n0, a.in[17], (bf16*)(ws + WS_WKV), DM, n0, 64 * kb, scr, lane); return; } r -= T_KV;
    if (r < T_Q) { const int l = r / I_SQ, q = r % I_SQ; const int nblk = DM / 32, kb = q / nblk, nb = q % nblk, n0 = 32 * nb;
        p0_transpose_item(a.in[19] + (size_t)l * DM * DM, DM, n0, a.in[4] + (NA + l) * DM, (bf16*)(ws + WS_WQ + (size_t)l * 2 * MiB), DM, n0, 64 * kb, scr, lane); return; } r -= T_Q;
    { const int l = r / I_SQ, q = r % I_SQ; const int nblk = DM / 32, kb = q / nblk, nb = q % nblk, n0 = 32 * nb;
        p0_transpose_item(a.in[20] + (size_t)l * DM * DM, DM, n0, nullptr, (bf16*)(ws + WS_WO + (size_t)l * 2 * MiB), DM, n0, 64 * kb, scr, lane); }
}
__device__ __forceinline__ void convert_ranges(const Args& a, LAS unsigned char* lds, int worker, int nworkers, int lo0, int n0, int lo1, int n1, int lo2, int n2, int lo3, int n3) {
    int tid_o = threadIdx.x; asm volatile("" : "+v"(tid_o)); const int lane = tid_o & 63, wave = __builtin_amdgcn_readfirstlane(tid_o >> 6);
    LAS float* scr = (LAS float*)(lds + RING_OFF + wave * 16384); unsigned char* ws = opq(a.ws);
    int off = worker;
    for (; off < n0; off += nworkers) convert_item(a, ws, lo0 + off, scr, lane); off -= n0;
    for (; off < n1; off += nworkers) convert_item(a, ws, lo1 + off, scr, lane); off -= n1;
    for (; off < n2; off += nworkers) convert_item(a, ws, lo2 + off, scr, lane); off -= n2;
    for (; off < n3; off += nworkers) convert_item(a, ws, lo3 + off, scr, lane);
}
__device__ __forceinline__ void convert_tail_slot(const Args& a, LAS unsigned char* lds, int j, int worker, int nworkers) {
    if (j >= 7) return;
    int lo2 = 0, n2 = 0, lo3 = 0, n3 = 0;
    if (j == 0) { lo2 = IT_GLU; n2 = I_GLU; } else if (j == 1) { lo2 = IT_GLU + I_GLU; n2 = I_GLU; } else if (j == 2) { lo2 = IT_KV; n2 = I_KV; }
    else if (j == 3) { lo2 = IT_Q; n2 = I_SQ; lo3 = IT_O; n3 = I_SQ; } else if (j == 5) { lo2 = IT_Q + I_SQ; n2 = I_SQ; lo3 = IT_O + I_SQ; n3 = I_SQ; }
    convert_ranges(a, lds, worker, nworkers, (j + 1) * I_IN, I_IN, IT_OUT + (j + 1) * I_OUT, I_OUT, lo2, n2, lo3, n3);
}
__device__ __forceinline__ void phase_prologue(const Args& a, LAS unsigned char* lds, int vcu, int G) {
    int tid_o = threadIdx.x; asm volatile("" : "+v"(tid_o)); const int lane = tid_o & 63, wave = __builtin_amdgcn_readfirstlane(tid_o >> 6);
    for (int item = vcu; item < 2 * NA * SG; item += G) s5::s5_gen_item(a, lds + RING_OFF, item);
    const int gw = vcu * NWAVES + wave, NGW = G * NWAVES;
    unsigned char* ws = a.ws;
    if (G == 256) convert_ranges(a, lds, gw, NGW, 0, I_IN, IT_OUT, I_OUT, 0, 0, 0, 0);
    else convert_ranges(a, lds, gw, NGW, 0, NITEMS, 0, 0, 0, 0, 0, 0);
    const float* x = a.in[0]; bf16* hb = (bf16*)(ws + WS_HB); pg8::stat_t* st0 = (pg8::stat_t*)(ws + WS_STATS);
    for (int m = gw; m < M; m += 2 * NGW) {
        const bool two = (m + NGW < M); const int m2 = two ? m + NGW : m; f32x4 v[2][4];
#pragma unroll
        for (int j = 0; j < 4; ++j) { v[0][j] = ((const f32x4*)(x + (size_t)m * DM) + lane)[64 * j]; v[1][j] = ((const f32x4*)(x + (size_t)m2 * DM) + lane)[64 * j]; }
#pragma unroll
        for (int q = 0; q < 2; ++q) { if (q && !two) break; const int mm = q ? m2 : m; unsigned long long* o8 = (unsigned long long*)(hb + (size_t)mm * DM) + lane; float s = 0.f;
#pragma unroll
            for (int j = 0; j < 4; ++j) { const f32x4 w = v[q][j]; s += (w.x * w.x + w.y * w.y) + (w.z * w.z + w.w * w.w); o8[64 * j] = (unsigned long long)pk2(w.x, w.y) | ((unsigned long long)pk2(w.z, w.w) << 32); }
            s = wave_sum(s); if (lane == 0) st0[mm] = (pg8::stat_t)(s * 4294967296.0f); }
    }
}
__device__ __forceinline__ void phase_final(const Args& a, int vcu, int G) {
    int tid_o = threadIdx.x; asm volatile("" : "+v"(tid_o)); const int lane = tid_o & 63, wave = __builtin_amdgcn_readfirstlane(tid_o >> 6);
    const int gw = vcu * NWAVES + wave, NGW = G * NWAVES; const float* gn = a.in[21]; const bf16* hb = (const bf16*)(opq(a.ws) + WS_HB);
    f32x4 g[4];
#pragma unroll
    for (int j = 0; j < 2; ++j) { g[2 * j] = *(const f32x4*)(gn + 512 * j + 8 * lane); g[2 * j + 1] = *(const f32x4*)(gn + 512 * j + 8 * lane + 4); }
    for (int m0 = gw; m0 < M; m0 += 4 * NGW) {
        v4u w[4][2];
#pragma unroll
        for (int q = 0; q < 4; ++q) { const size_t m = (size_t)(m0 + q * NGW < M ? m0 + q * NGW : m0); w[q][0] = *(const v4u*)(hb + m * DM + 8 * lane); w[q][1] = *(const v4u*)(hb + m * DM + 512 + 8 * lane); }
#pragma unroll
        for (int q = 0; q < 4; ++q) { if (m0 + q * NGW >= M) break; const size_t m = (size_t)(m0 + q * NGW); const v4u w0 = w[q][0], w1 = w[q][1];
            f32x4 v[4]; v[0] = (f32x4){bf_lo(w0.x), bf_hi(w0.x), bf_lo(w0.y), bf_hi(w0.y)}; v[1] = (f32x4){bf_lo(w0.z), bf_hi(w0.z), bf_lo(w0.w), bf_hi(w0.w)};
            v[2] = (f32x4){bf_lo(w1.x), bf_hi(w1.x), bf_lo(w1.y), bf_hi(w1.y)}; v[3] = (f32x4){bf_lo(w1.z), bf_hi(w1.z), bf_lo(w1.w), bf_hi(w1.w)};
            float s = 0.f;
#pragma unroll
            for (int j = 0; j < 4; ++j) s += (v[j].x * v[j].x + v[j].y * v[j].y) + (v[j].z * v[j].z + v[j].w * v[j].w);
            const float r = rsqrtf(wave_sum(s) * (1.0f / DM) + 1e-6f);
            float* o = a.out + m * DM + 8 * lane;
            *(f32x4*)(o) = v[0] * r * g[0]; *(f32x4*)(o + 4) = v[1] * r * g[1]; *(f32x4*)(o + 512) = v[2] * r * g[2]; *(f32x4*)(o + 516) = v[3] * r * g[3]; }
    }
}
#include <hip/hip_bf16.h>
#include <cmath>
namespace attn_body {
using bf16=__hip_bfloat16;
using bf16x8=__attribute__((ext_vector_type(8)))short;
using s16x4=__attribute__((ext_vector_type(4)))short;
using f32x16=__attribute__((ext_vector_type(16)))float;
using u32x4=__attribute__((ext_vector_type(4)))unsigned;
constexpr int BATCH=8,NHEAD=16,SEQ=2048,D=64,DM=NHEAD*D;
constexpr int NW=8,QBLK=32,QB=QBLK*NW,KVBLK=64,NQB=SEQ/QB;
constexpr int ATTN_PITCH=DM, ATTN_UNIT_ROWS=QB;
__device__ __forceinline__ int crow(int r,int hi){return (r&3)+8*(r>>2)+4*hi;}
#define SBAR() __builtin_amdgcn_sched_barrier(0)
__device__ __forceinline__ void cmask(f32x16&p0,f32x16&p1,int jb,int qrel,int hi){
  const float NEG=-INFINITY; int kb=64*jb+4*hi;
  #pragma unroll
  for(int r=0;r<16;++r){int kv=kb+(r&3)+8*(r>>2); if(kv>qrel)p0[r]=NEG; if(kv+32>qrel)p1[r]=NEG;}
}

typedef float f32x4_t __attribute__((ext_vector_type(4)));
__device__ __forceinline__ float bfu(short x){ return __uint_as_float(((unsigned)(unsigned short)x)<<16); }
constexpr int NSLOT=3, SLOTB=8192;
constexpr int LDS_K=0, LDS_V=NSLOT*SLOTB, LDS_WS=2*NSLOT*SLOTB, LDS_OST=LDS_WS+NW*64*4, LDS_KM=LDS_OST+NW*4096, LDS_BYTES=LDS_KM+8*64*4;
constexpr float C2=0.125f*1.4426950408889634f;
__device__ __forceinline__ void glds16(const void*gsrc,unsigned lds_dst){unsigned keep;
  asm volatile("s_mov_b32 %0, m0\n\ts_mov_b32 m0, %2\n\ts_nop 0\n\tglobal_load_lds_dwordx4 %1, off\n\ts_mov_b32 m0, %0":"=&s"(keep):"v"(gsrc),"s"(lds_dst):"memory");}
__device__ __forceinline__ float max3f(float a,float b,float c){float r;asm("v_max3_f32 %0, %1, %2, %3":"=v"(r):"v"(a),"v"(b),"v"(c));return r;}
__device__ __forceinline__ float max2f(float a,float b){float r;asm("v_max_f32_e32 %0, %1, %2":"=v"(r):"v"(a),"v"(b));return r;}
__device__ __forceinline__ float fadd_s(float a,float b){float r;asm("v_add_f32_e32 %0, %1, %2":"=v"(r):"v"(a),"v"(b));return r;}
__device__ __forceinline__ float fsub_s(float a,float b){float r;asm("v_sub_f32_e32 %0, %1, %2":"=v"(r):"v"(a),"v"(b));return r;}
typedef float f32x2_t __attribute__((ext_vector_type(2))); typedef __bf16 bf16x2_t __attribute__((ext_vector_type(2)));
__device__ __forceinline__ unsigned cvtpk_s(float lo,float hi){f32x2_t v={lo,hi};bf16x2_t b=__builtin_convertvector(v,bf16x2_t);return __builtin_bit_cast(unsigned,b);}
#define WAIT_BAR(N) asm volatile("s_waitcnt vmcnt(" #N ") lgkmcnt(0)\n\ts_barrier":::"memory")

__device__ __forceinline__ void qkt(f32x16&p0,f32x16&p1,const char*Kslot,const bf16x8*qr,const f32x16&c0i,const f32x16&c1i,int r32,int hi){
  const char*kb=Kslot+hi*1024+r32*16;
  #pragma unroll
  for(int d0=0;d0<4;++d0){
    const bf16x8 b0=*reinterpret_cast<const bf16x8*>(kb+d0*2048);
    const bf16x8 b1=*reinterpret_cast<const bf16x8*>(kb+d0*2048+512);
    if(d0==0){p0=__builtin_amdgcn_mfma_f32_32x32x16_bf16(b0,qr[0],c0i,0,0,0);p1=__builtin_amdgcn_mfma_f32_32x32x16_bf16(b1,qr[0],c1i,0,0,0);}
    else{p0=__builtin_amdgcn_mfma_f32_32x32x16_bf16(b0,qr[d0],p0,0,0,0);p1=__builtin_amdgcn_mfma_f32_32x32x16_bf16(b1,qr[d0],p1,0,0,0);}}
}
typedef __attribute__((address_space(3))) const char* lds_cptr;
typedef short v4i16_t __attribute__((ext_vector_type(4)));
__device__ __forceinline__ void kload8(bf16x8*kf,lds_cptr kp){
  kf[0]=*(const __attribute__((address_space(3))) bf16x8*)(kp);      kf[1]=*(const __attribute__((address_space(3))) bf16x8*)(kp+512);
  kf[2]=*(const __attribute__((address_space(3))) bf16x8*)(kp+2048); kf[3]=*(const __attribute__((address_space(3))) bf16x8*)(kp+2560);
  kf[4]=*(const __attribute__((address_space(3))) bf16x8*)(kp+4096); kf[5]=*(const __attribute__((address_space(3))) bf16x8*)(kp+4608);
  kf[6]=*(const __attribute__((address_space(3))) bf16x8*)(kp+6144); kf[7]=*(const __attribute__((address_space(3))) bf16x8*)(kp+6656);
}
__device__ __forceinline__ void kload2(bf16x8*kf,lds_cptr kp,int j){ kf[2*j]=*(const __attribute__((address_space(3))) bf16x8*)(kp+j*2048); kf[2*j+1]=*(const __attribute__((address_space(3))) bf16x8*)(kp+j*2048+512); }
__device__ __forceinline__ s16x4 vtr(lds_cptr p){ return __builtin_bit_cast(s16x4,__builtin_amdgcn_ds_read_tr16_b64_v4i16((__attribute__((address_space(3))) v4i16_t*)p)); }
__device__ __forceinline__ float rowmax(const f32x16&p0,const f32x16&p1){
  float a=max3f(p0[0],p0[1],p1[0]),b=max3f(p0[2],p0[3],p1[1]);a=max3f(a,p1[2],p1[3]);
  #pragma unroll
  for(int r=4;r<16;r+=4){a=max3f(a,p0[r],p0[r+1]);b=max3f(b,p0[r+2],p0[r+3]);a=max3f(a,p1[r],p1[r+1]);b=max3f(b,p1[r+2],p1[r+3]);}
  const float m=max2f(a,b);
  auto rr=__builtin_amdgcn_permlane32_swap(__float_as_uint(m),__float_as_uint(m),false,false);
  return max2f(__uint_as_float(rr[0]),__uint_as_float(rr[1]));
}
__device__ __forceinline__ void pv(f32x16*o,int vb,bf16x8 pa0,bf16x8 pa1,bf16x8 pa2,bf16x8 pa3){
  #pragma unroll
  for(int d0=0;d0<2;++d0){s16x4 lo[4],hi[4];
    #pragma unroll
    for(int ks=0;ks<4;++ks){
      asm volatile("ds_read_b64_tr_b16 %0,%1 offset:%c2":"=&v"(lo[ks]):"v"(vb),"i"(d0*4096+ks*1024):"memory");
      asm volatile("ds_read_b64_tr_b16 %0,%1 offset:%c2":"=&v"(hi[ks]):"v"(vb),"i"(d0*4096+ks*1024+512):"memory");}
    asm volatile("s_waitcnt lgkmcnt(0)":::"memory");SBAR();
    #define PK(k) (bf16x8){lo[k][0],lo[k][1],lo[k][2],lo[k][3],hi[k][0],hi[k][1],hi[k][2],hi[k][3]}
    o[d0]=__builtin_amdgcn_mfma_f32_32x32x16_bf16(pa0,PK(0),o[d0],0,0,0);
    o[d0]=__builtin_amdgcn_mfma_f32_32x32x16_bf16(pa1,PK(1),o[d0],0,0,0);
    o[d0]=__builtin_amdgcn_mfma_f32_32x32x16_bf16(pa2,PK(2),o[d0],0,0,0);
    o[d0]=__builtin_amdgcn_mfma_f32_32x32x16_bf16(pa3,PK(3),o[d0],0,0,0);
    #undef PK
  }
}

#ifndef ATTN_STORE16
#define ATTN_STORE16(p,v) (*(u32x4*)(p)=(v))
#endif
template<int THRL> __device__ __forceinline__ void attn_unit(int b,int h,int qb,const bf16*Q,const bf16*__restrict__ K,const bf16*__restrict__ V,bf16*O,const float*__restrict__ kmp,char*shm){
  int tid_o=threadIdx.x; asm volatile("":"+v"(tid_o));
  const int tid=tid_o,lane=tid&63,r32=lane&31,hi=lane>>5; const int wid=__builtin_amdgcn_readfirstlane(tid>>6);
  const long rowbase=(long)b*SEQ; const int q0=qb*QB;
  const bf16*Qw=Q+(rowbase+q0+wid*QBLK)*DM+h*D;
  const bf16*Kh=K+rowbase*DM+h*D,*Vh=V+rowbase*DM+h*D;
  float*kmt=(float*)(shm+LDS_KM);
  const float kmv=(kmp[((size_t)(b*8+(tid>>6)))*DM+h*D+(tid&63)]+kmp[(size_t)64*DM+((size_t)(b*8+(tid>>6)))*DM+h*D+(tid&63)])*(1.0f/256.0f);
  const float slope2=__builtin_amdgcn_exp2f(-0.5f*(float)(h+1))*1.4426950408889634f;
  const unsigned lds0=(unsigned)(uintptr_t)shm;
  float*wsf=(float*)(shm+LDS_WS)+wid*64;
  const bf16*ksrc=Kh+(long)lane*DM+wid*8;
  const bf16*vsrc=Vh+(long)(16*(wid&3)+(lane>>2))*DM+(wid>>2)*32+(lane&3)*8;
  const unsigned kdst=lds0+LDS_K+wid*1024, vdst=lds0+LDS_V+wid*1024;
  #define DMA_K(t,slot) glds16(ksrc+(long)(t)*KVBLK*DM,(unsigned)__builtin_amdgcn_readfirstlane(kdst+(slot)))
  #define DMA_V(t,slot) glds16(vsrc+(long)(t)*KVBLK*DM,(unsigned)__builtin_amdgcn_readfirstlane(vdst+(slot)))
  const int vb0=(int)(lds0+LDS_V)+((lane>>4)&1)*32+(lane&3)*8+(4*hi+((lane&15)>>2))*64;
  const char*Kbase=shm+LDS_K; bf16x8 kf[8];
  const lds_cptr shm3=(lds_cptr)shm; const lds_cptr kp0=shm3+LDS_K+hi*1024+r32*16; const lds_cptr vp0=shm3+LDS_V+((lane>>4)&1)*32+(lane&3)*8+(4*hi+((lane&15)>>2))*64;
  const int NT=(q0+QB)/KVBLK;
  DMA_K(0,0);DMA_V(0,0);DMA_K(1,SLOTB);
  bf16x8 qr[4];
  #pragma unroll
  for(int d0=0;d0<4;++d0)qr[d0]=*reinterpret_cast<const bf16x8*>(&Qw[(long)r32*DM+d0*16+hi*8]);
  float mhat=0.f,l_reg=0.f;f32x16 o[2];o[0]=f32x16{};o[1]=f32x16{};
  const int qrel=wid*QBLK+r32;
  f32x16 cb; _Pragma("unroll") for(int r=0;r<16;++r)cb[r]=slope2*(float)crow(r,hi); asm volatile("":"+v"(cb));
  float nmq=-slope2*(float)(q0+qrel);
  const float s64=slope2*64.0f, s32=slope2*32.0f; unsigned sel=0u;
  kmt[tid]=kmv;
  #define CMASK(P0,P1,t) do{int jb_=(t)-(NT-4); if(jb_>=0)cmask(P0,P1,jb_,qrel,hi);}while(0)
  #define MASKV (-30000.0f)
  #define CINIT(C0,C1,t) do{ const float mk_=((sel>>((t)>>2))&1u)?0.f:MASKV; const float b0_=nmq+s64*(float)(t)+mk_, b1_=b0_+s32; \
    _Pragma("unroll") for(int r=0;r<16;++r){C0[r]=cb[r]+b0_;C1[r]=cb[r]+b1_;} }while(0)
  bool resc=false;
  #define RESC() do{ if(resc){ asm volatile("s_waitcnt lgkmcnt(0)":::"memory"); \
      _Pragma("unroll") for(int d_=0;d_<2;++d_) _Pragma("unroll") for(int r=0;r<16;++r)o[d_][r]*=wsf[crow(r,hi)]; } }while(0)
  f32x16 pA0,pA1,pB0,pB1;
  int sl_prev=0,sl_cur=0,sl_next=SLOTB;
  #define ROT() do{sl_prev=sl_cur;sl_cur=sl_next;sl_next=(sl_next==(NSLOT-1)*SLOTB)?0:sl_next+SLOTB;}while(0)
  DMA_K(2,2*SLOTB);
  WAIT_BAR(3);
  { float gt[8];
    _Pragma("unroll") for(int n=0;n<8;++n){ float sg=0.f;
      _Pragma("unroll") for(int d0=0;d0<4;++d0){ const float*kp_=kmt+n*64+d0*16+hi*8; const f32x4_t k0_=*(const f32x4_t*)kp_, k1_=*(const f32x4_t*)(kp_+4);
        sg+=(bfu(qr[d0][0])*k0_[0]+bfu(qr[d0][1])*k0_[1])+(bfu(qr[d0][2])*k0_[2]+bfu(qr[d0][3])*k0_[3])+(bfu(qr[d0][4])*k1_[0]+bfu(qr[d0][5])*k1_[1])+(bfu(qr[d0][6])*k1_[2]+bfu(qr[d0][7])*k1_[3]); }
      { auto rr=__builtin_amdgcn_permlane32_swap(__float_as_uint(sg),__float_as_uint(sg),false,false); sg=__uint_as_float(rr[0])+__uint_as_float(rr[1]); }
      gt[n]=(n<qb)?sg:-3.0e38f; }
    const int nsel=qb<3?qb:3;
    for(int r_=0;r_<nsel;++r_){ float best=-3.0e38f; int bi=0;
      _Pragma("unroll") for(int n=0;n<8;++n){ const bool ok=(n<qb)&&!((sel>>n)&1u)&&(gt[n]>best); if(ok){best=gt[n];bi=n;} }
      sel|=1u<<bi; }
    sel|=1u<<qb; }
  CINIT(pA0,pA1,0);
  qkt(pA0,pA1,Kbase,qr,pA0,pA1,r32,hi);asm volatile("s_nop 15\n\ts_nop 7":"+v"(pA0),"+v"(pA1));CMASK(pA0,pA1,0);
  { const float rm=rowmax(pA0,pA1);
    if(__any(rm>(float)THRL)){ const float dl=__builtin_fmaxf(rm,0.f); mhat+=dl; nmq-=dl;
      _Pragma("unroll") for(int r=0;r<16;++r){pA0[r]-=dl;pA1[r]-=dl;} } }
  _Pragma("unroll") for(int r=0;r<16;++r)pA0[r]=__builtin_amdgcn_exp2f(pA0[r]);
  _Pragma("unroll") for(int r=0;r<16;++r)pA1[r]=__builtin_amdgcn_exp2f(pA1[r]);
  WAIT_BAR(0);
  DMA_K(3,0);DMA_V(1,SLOTB);
  ROT();
  kload8(kf,kp0+sl_cur);
  WAIT_BAR(2);
  s16x4 vlo[8],vhi[8]; u32x4 pw0,pw1,pw2,pw3;
  #define PKW(P,B) cvtpk_s(P[B],P[B+1])
  #define PAF(k) __builtin_bit_cast(bf16x8,pw##k)
  #define VFR(i) (bf16x8){vlo[i][0],vlo[i][1],vlo[i][2],vlo[i][3],vhi[i][0],vhi[i][1],vhi[i][2],vhi[i][3]}
  #define PIN(x) asm volatile("":"+v"(x))
  #define MX3(a,b,c) __builtin_fmaxf(__builtin_fmaxf((a),(b)),(c))
  #define GAPA(MF,A0,A1,A2,A3,W0,W1,PW) do{ MF; sacc+=A0; sacc+=A1; sacc+=A2; sacc+=A3; PIN(sacc); W0; W1; PIN(PW); SBAR(); }while(0)
  #define EX(v) __builtin_amdgcn_exp2f(v)
  #define GAPB(MF,X,B) do{ MF; X[B]=EX(X[B]); X[B+1]=EX(X[B+1]); X[B+2]=EX(X[B+2]); X[B+3]=EX(X[B+3]); PIN(X); SBAR(); }while(0)
  #define VRD(i) do{ vlo[i]=vtr(vp_+(((i)>>2)*4096+((i)&3)*1024)); vhi[i]=vtr(vp_+(((i)>>2)*4096+((i)&3)*1024+512)); }while(0)
  #define KRD(G,j) do{ if(G){ kload2(kf,kp0+sl_next,j); SBAR(); } }while(0)
  #define STEP(C0,C1,P0,P1,t,GK,GV,GL) do{ SBAR(); \
    CINIT(C0,C1,t); SBAR(); \
    const lds_cptr vp_=vp0+sl_prev; \
    VRD(0); SBAR(); float sacc=(P0[0]+P0[1]); \
    GAPA(C0=__builtin_amdgcn_mfma_f32_32x32x16_bf16(kf[0],qr[0],C0,0,0,0), P0[2],P0[3],P0[4],P0[5],     pw0[0]=PKW(P0,0), pw0[1]=PKW(P0,2), pw0); \
    VRD(4); SBAR(); GAPA(C1=__builtin_amdgcn_mfma_f32_32x32x16_bf16(kf[1],qr[0],C1,0,0,0), P0[6],P0[7],P0[8],P0[9],     pw0[2]=PKW(P0,4), pw0[3]=PKW(P0,6), pw0); \
    VRD(1); SBAR(); GAPA(C0=__builtin_amdgcn_mfma_f32_32x32x16_bf16(kf[2],qr[1],C0,0,0,0),   P0[10],P0[11],P0[12],P0[13], pw1[0]=PKW(P0,8), pw1[1]=PKW(P0,10), pw1); \
    VRD(5); SBAR(); GAPA(C1=__builtin_amdgcn_mfma_f32_32x32x16_bf16(kf[3],qr[1],C1,0,0,0),   P0[14],P0[15],P1[0],P1[1],   pw1[2]=PKW(P0,12),pw1[3]=PKW(P0,14), pw1); \
    VRD(2); SBAR(); GAPA(C0=__builtin_amdgcn_mfma_f32_32x32x16_bf16(kf[4],qr[2],C0,0,0,0),   P1[2],P1[3],P1[4],P1[5],     pw2[0]=PKW(P1,0), pw2[1]=PKW(P1,2), pw2); \
    VRD(6); SBAR(); GAPA(C1=__builtin_amdgcn_mfma_f32_32x32x16_bf16(kf[5],qr[2],C1,0,0,0),   P1[6],P1[7],P1[8],P1[9],     pw2[2]=PKW(P1,4), pw2[3]=PKW(P1,6), pw2); \
    VRD(3); SBAR(); GAPA(C0=__builtin_amdgcn_mfma_f32_32x32x16_bf16(kf[6],qr[3],C0,0,0,0),   P1[10],P1[11],P1[12],P1[13], pw3[0]=PKW(P1,8), pw3[1]=PKW(P1,10), pw3); \
    VRD(7); SBAR(); GAPA(C1=__builtin_amdgcn_mfma_f32_32x32x16_bf16(kf[7],qr[3],C1,0,0,0),   P1[14],P1[15],0.f,0.f,       pw3[2]=PKW(P1,12),pw3[3]=PKW(P1,14), pw3); \
    l_reg+=sacc; \
    if(GK){DMA_K((t)+3,sl_cur);} if(GV){DMA_V((t)+1,sl_next);} \
    CMASK(C0,C1,t); \
    { float a=MX3(C0[0],C0[1],C1[0]),b=MX3(C0[2],C0[3],C1[1]); a=MX3(a,C1[2],C1[3]); \
      _Pragma("unroll") for(int r=4;r<16;r+=4){a=MX3(a,C0[r],C0[r+1]);b=MX3(b,C0[r+2],C0[r+3]);a=MX3(a,C1[r],C1[r+1]);b=MX3(b,C1[r+2],C1[r+3]);} \
      float rm=__builtin_fmaxf(a,b); { auto rr=__builtin_amdgcn_permlane32_swap(__float_as_uint(rm),__float_as_uint(rm),false,false); rm=__builtin_fmaxf(__uint_as_float(rr[0]),__uint_as_float(rr[1])); } \
      resc=false; \
      if(__builtin_expect(__any(rm>(float)THRL),0)){ const float dl=__builtin_fmaxf(rm,0.f); mhat+=dl; \
        _Pragma("unroll") for(int r=0;r<16;++r){C0[r]-=dl;C1[r]-=dl;} \
        nmq-=dl; \
        const float f=__builtin_amdgcn_exp2f(-dl); l_reg*=f; if(hi==0)wsf[r32]=f; resc=true; } } \
    SBAR(); \
    GAPB(o[0]=__builtin_amdgcn_mfma_f32_32x32x16_bf16(PAF(0),VFR(0),o[0],0,0,0), C0,0); \
    GAPB(o[1]=__builtin_amdgcn_mfma_f32_32x32x16_bf16(PAF(0),VFR(4),o[1],0,0,0), C0,4); \
    KRD(GL,0); GAPB(o[0]=__builtin_amdgcn_mfma_f32_32x32x16_bf16(PAF(1),VFR(1),o[0],0,0,0), C0,8); \
    KRD(GL,1); GAPB(o[1]=__builtin_amdgcn_mfma_f32_32x32x16_bf16(PAF(1),VFR(5),o[1],0,0,0), C0,12); \
    KRD(GL,2); GAPB(o[0]=__builtin_amdgcn_mfma_f32_32x32x16_bf16(PAF(2),VFR(2),o[0],0,0,0), C1,0); \
    KRD(GL,3); GAPB(o[1]=__builtin_amdgcn_mfma_f32_32x32x16_bf16(PAF(2),VFR(6),o[1],0,0,0), C1,4); \
    GAPB(o[0]=__builtin_amdgcn_mfma_f32_32x32x16_bf16(PAF(3),VFR(3),o[0],0,0,0), C1,8); \
    GAPB(o[1]=__builtin_amdgcn_mfma_f32_32x32x16_bf16(PAF(3),VFR(7),o[1],0,0,0), C1,12); \
    }while(0)
  int t=1;
  #undef CMASK
  #define CMASK(P0,P1,t) do{}while(0)
  for(;t+5<NT;t+=2){
    STEP(pB0,pB1,pA0,pA1,t,true,true,true);     WAIT_BAR(2); RESC(); ROT();
    STEP(pA0,pA1,pB0,pB1,t+1,true,true,true);   WAIT_BAR(2); RESC(); ROT();
  }
  #undef CMASK
  #define CMASK(P0,P1,t) do{int jb_=(t)-(NT-4); if(jb_>=0)cmask(P0,P1,jb_,qrel,hi);}while(0)
  #define ENDW(tt) do{ if((tt)+3<NT){WAIT_BAR(2);} else if((tt)+2<NT){WAIT_BAR(1);} else {WAIT_BAR(0);} }while(0)
  for(;t+1<NT;t+=2){
    STEP(pB0,pB1,pA0,pA1,t,(t+3<NT),(t+1<NT),(t+1<NT));       ENDW(t);   RESC(); ROT();
    STEP(pA0,pA1,pB0,pB1,t+1,(t+4<NT),(t+2<NT),(t+2<NT));     ENDW(t+1); RESC(); ROT();
  }
  STEP(pB0,pB1,pA0,pA1,NT-1,false,false,false); RESC();
  { float sacc=pB0[0]+pB0[1]; _Pragma("unroll") for(int r=2;r<16;++r)sacc+=pB0[r]; _Pragma("unroll") for(int r=0;r<16;++r)sacc+=pB1[r]; l_reg+=sacc;
    pw0=(u32x4){PKW(pB0,0),PKW(pB0,2),PKW(pB0,4),PKW(pB0,6)};pw1=(u32x4){PKW(pB0,8),PKW(pB0,10),PKW(pB0,12),PKW(pB0,14)};pw2=(u32x4){PKW(pB1,0),PKW(pB1,2),PKW(pB1,4),PKW(pB1,6)};pw3=(u32x4){PKW(pB1,8),PKW(pB1,10),PKW(pB1,12),PKW(pB1,14)};
    SBAR(); pv(o,vb0+sl_cur,PAF(0),PAF(1),PAF(2),PAF(3)); }
  #undef PKW
  #undef PAF
  #undef VFR
  #undef PIN
  #undef MX3
  #undef GAPA
  #undef GAPB
  #undef EX
  #undef VRD
  #undef KRD
  #undef STEP
  #undef ENDW
  {auto rr=__builtin_amdgcn_permlane32_swap(__float_as_uint(l_reg),__float_as_uint(l_reg),false,false);l_reg=__uint_as_float(rr[0])+__uint_as_float(rr[1]);}
  if(hi==0)wsf[32+r32]=l_reg;asm volatile("s_waitcnt lgkmcnt(0)":::"memory");
  float rli[16];
  #pragma unroll
  for(int r=0;r<16;++r)rli[r]=__builtin_amdgcn_rcpf(wsf[32+crow(r,hi)]);
  bf16*Ow=O+(rowbase+q0+wid*QBLK)*DM+h*D;
  { bf16*stg=(bf16*)(shm+LDS_OST)+wid*2048;
    #pragma unroll
    for(int r=0;r<16;++r){const int orow=crow(r,hi);
      #pragma unroll
      for(int d0=0;d0<2;++d0)stg[orow*64+d0*32+r32]=__float2bfloat16(o[d0][r]*rli[r]);}
    asm volatile("s_waitcnt lgkmcnt(0)":::"memory");
    #pragma unroll
    for(int i=0;i<4;++i){const int row=i*8+(lane>>3),ch=lane&7; const u32x4 v=*(const u32x4*)(stg+row*64+ch*8); ATTN_STORE16(Ow+(long)row*DM+ch*8,v);} }
  asm volatile("s_waitcnt lgkmcnt(0)\n\ts_barrier":::"memory");
  #undef DMA_K
  #undef DMA_V
  #undef CMASK
  #undef CINIT
  #undef MASKV
  #undef RESC
  #undef ROT
}
constexpr int ATTN_LDS_BYTES=LDS_BYTES;
struct AttnTensors { const bf16* Q; const bf16* K; const bf16* V; bf16* O; const float* kmp; };
template<int THRL=8> __device__ __forceinline__ void attn_phase(char*lds,const AttnTensors&T,int G,int c0){
  for(int u=c0;u<BATCH*NHEAD*NQB;u+=G){
    const int kq=u>>8,c=u&255,bh=((c>>4)<<3)|(c&7),sub=(c>>3)&1;
    const int qb=sub?((kq==0)?2:(kq==1)?5:(kq==2)?3:4):((kq==0)?0:(kq==1)?7:(kq==2)?1:6);
    attn_unit<THRL>(bh/NHEAD,bh%NHEAD,qb,T.Q,T.K,T.V,T.O,T.kmp,lds); }
}
#undef SBAR
#undef WAIT_BAR
}

constexpr unsigned DUP_MASK = 0u; constexpr int S5_PROBE_VAR = 0;
#ifndef MK_ONE_LAUNCH
#define MK_ONE_LAUNCH 1
#endif
__global__ void __launch_bounds__(NTHR, 2) mk_fwd(Args a) {
    extern __shared__ __attribute__((aligned(16))) unsigned char lds_raw[];
    LAS unsigned char* lds = (LAS unsigned char*)lds_raw;
    volatile LAS unsigned* MISC = (volatile LAS unsigned*)(lds + MISC_OFF);
    const int tid = threadIdx.x, lane = tid & 63, wave = __builtin_amdgcn_readfirstlane(tid >> 6);
    const int G = gridDim.x; const int bx = blockIdx.x; const int vcu = (G % 8 == 0) ? (bx % 8) * (G / 8) + bx / 8 : bx;
    gu32* ctl = (gu32*)(a.ws + WS_CTL);
    for (int u = tid; u < (LDS_BYTES - LDSCTL_OFF) / 4; u += NTHR) ((LAS unsigned*)(lds + LDSCTL_OFF))[u] = 0u;
    __syncthreads();
    const int lo = a.ph_lo, hi = a.ph_hi; const bool multi = (hi - lo) > 1;
    XcdBarrier bar; bar.bar = (unsigned*)(ctl + CW_BAR); bar.x = 0; bar.st = nullptr;
    if (multi) bar = xcd_barrier_post((unsigned*)(ctl + CW_BAR), MISC + 8);
    int pid = 0;
#define IN_PH() (lo <= pid && pid < hi)
#define PH_REP(kb) for (int rep_ = 0; rep_ < 1 + (int)((DUP_MASK >> (kb)) & 1u); ++rep_)
#define END_PH() do { if (IN_PH() && pid + 1 < hi) xcd_barrier(bar); ++pid; } while (0)
    if (IN_PH()) PH_REP(0) phase_prologue(a, lds, vcu, G);
    END_PH();
    int sidx = 0;
#pragma nounroll
    for (int l = 0; l < DEPTH; ++l) {
#pragma nounroll
        for (int sub = 0; sub < 3; ++sub) {
            if (sub != 1) {
                const int f = sub >> 1, j = 2 * l + f;
                if (IN_PH()) PH_REP(1) { unsigned char* ws = opq(a.ws); pg8::stat_t* stats = (pg8::stat_t*)(ws + WS_STATS); bf16* hb = (bf16*)(ws + WS_HB); bf16* act = (bf16*)(ws + WS_ACT); (void)stats; (void)hb; (void)act; pg8::Gemm g{hb, (const bf16*)(ws + WS_WIN + (size_t)j * WIN_BYTES), M, 2 * DFF, DM}; pg8::StaticOrder S; S.init(M, 2 * DFF, G, bx);
                    pg8::EpiSwiGLU E{act, DFF, stats + (size_t)sidx * M};
                    pg8::gemm_phase<pg8::EpiSwiGLU, pg8::StaticOrder, true, true>(lds + RING_OFF, g, S, E);
                    if (G == 256 && bx >= 128 && rep_ == 0) convert_tail_slot(a, lds, j, (bx - 128) * NWAVES + __builtin_amdgcn_readfirstlane(threadIdx.x >> 6), 128 * NWAVES); }
                END_PH();
                if (IN_PH()) { unsigned char* ws = opq(a.ws); pg8::stat_t* stats = (pg8::stat_t*)(ws + WS_STATS); bf16* hb = (bf16*)(ws + WS_HB); bf16* act = (bf16*)(ws + WS_ACT); (void)stats; (void)hb; (void)act; pg8::Gemm g{act, (const bf16*)(ws + WS_WOUT + (size_t)j * WOUT_BYTES), M, DM, DFF}; pg8::StaticOrder S; S.init(M, DM, G, bx);
                    pg8::EpiRes E{hb, stats + (size_t)(sidx + 1) * M, 0.5f};
                    pg8::gemm_phase<pg8::EpiRes, pg8::StaticOrder, true, true>(lds + RING_OFF, g, S, E); }
                END_PH(); ++sidx;
            } else if (l < NA) {
                if (IN_PH()) PH_REP(2) { if (((DUP_MASK >> 2) & 1u) && rep_ == 0) s5::phase_s5<S5_PROBE_VAR>(a, lds + RING_OFF, l, (const pg8::stat_t*)(opq(a.ws) + WS_STATS) + (size_t)sidx * M, G); else s5::phase_s5<0>(a, lds + RING_OFF, l, (const pg8::stat_t*)(opq(a.ws) + WS_STATS) + (size_t)sidx * M, G); }
                END_PH();
                if (IN_PH()) { unsigned char* ws = opq(a.ws); pg8::stat_t* stats = (pg8::stat_t*)(ws + WS_STATS); bf16* hb = (bf16*)(ws + WS_HB); bf16* act = (bf16*)(ws + WS_ACT); (void)stats; (void)hb; (void)act; pg8::Gemm g{act, (const bf16*)(ws + WS_WGLU + (size_t)l * WGLU_BYTES), M, 2 * DM, DM}; pg8::StaticOrder S; S.init(M, 2 * DM, G, bx);
                    pg8::EpiGluRes E{hb, stats + (size_t)(sidx + 1) * M};
                    pg8::gemm_phase<pg8::EpiGluRes, pg8::StaticOrder, true, true>(lds + RING_OFF, g, S, E); }
                END_PH(); ++sidx;
            } else {
                const int jb = l - NA;
                if (IN_PH()) PH_REP(4) { unsigned char* ws = opq(a.ws); pg8::stat_t* stats = (pg8::stat_t*)(ws + WS_STATS); bf16* hb = (bf16*)(ws + WS_HB); bf16* act = (bf16*)(ws + WS_ACT); (void)stats; (void)hb; (void)act; pg8::Gemm g{hb, (const bf16*)(ws + WS_WQ + (size_t)jb * 2 * MiB), M, DM, DM}; pg8::StaticOrder S; S.init(M, DM, G, bx);
                    pg8::EpiRowScale<false> E{act, act, stats + (size_t)sidx * M, C2, nullptr};
                    pg8::gemm_phase<pg8::EpiRowScale<false>, pg8::StaticOrder, true, true>(lds + RING_OFF, g, S, E); }
                END_PH();
                if (IN_PH()) PH_REP(5) { unsigned char* ws = opq(a.ws);
                    const attn_body::AttnTensors AT{(const attn_body::bf16*)(ws + WS_ACT), (const attn_body::bf16*)(ws + WS_K), (const attn_body::bf16*)(ws + WS_V), (attn_body::bf16*)(ws + WS_ACT + 32 * MiB), (const float*)(ws + WS_KMP)};
                    attn_body::attn_phase<8>((char*)lds_raw + RING_OFF, AT, G, bx); }
                END_PH();
                if (IN_PH()) { unsigned char* ws = opq(a.ws); pg8::stat_t* stats = (pg8::stat_t*)(ws + WS_STATS); bf16* hb = (bf16*)(ws + WS_HB); bf16* act = (bf16*)(ws + WS_ACT); (void)stats; (void)hb; (void)act; pg8::Gemm g{(const bf16*)(ws + WS_ACT + 32 * MiB), (const bf16*)(ws + WS_WO + (size_t)jb * 2 * MiB), M, DM, DM}; pg8::StaticOrder S; S.init(M, DM, G, bx);
                    pg8::EpiRes E{hb, stats + (size_t)(sidx + 1) * M, 1.0f};
                    pg8::gemm_phase<pg8::EpiRes, pg8::StaticOrder, true, true>(lds + RING_OFF, g, S, E); }
                END_PH(); ++sidx;
            }
            if (l == NA - 1 && sub == 2) {
                if (IN_PH()) PH_REP(3) { unsigned char* ws = opq(a.ws); pg8::stat_t* stats = (pg8::stat_t*)(ws + WS_STATS); bf16* hb = (bf16*)(ws + WS_HB); bf16* act = (bf16*)(ws + WS_ACT); (void)stats; (void)hb; (void)act; pg8::Gemm g{hb, (const bf16*)(ws + WS_WKV), M, 2 * DM, DM}; pg8::StaticOrder S; S.init(M, 2 * DM, G, bx);
                    pg8::EpiRowScale<true> E{(bf16*)(ws + WS_K), (bf16*)(ws + WS_V), stats + (size_t)sidx * M, 1.0f, (float*)(ws + WS_KMP)};
                    pg8::gemm_phase<pg8::EpiRowScale<true>, pg8::StaticOrder, true, true>(lds + RING_OFF, g, S, E); }
            }
        }
    }
    if (IN_PH()) phase_final(a, vcu, G);
    ++pid;
#undef IN_PH
#undef END_PH
}

extern "C" void kernel_launch(void* const* d_in, const int* in_sizes, int n_in, void* d_out, int out_size, void* d_ws, size_t ws_size, hipStream_t stream) {
    static int grid = 0;
    if (grid == 0) {
        if (n_in != 22 || in_sizes[0] != M * DM || out_size != M * DM || ws_size < WS_END) { fprintf(stderr, "kernel_launch: unexpected shapes / workspace (n_in %d, ws %zu < %zu); nothing launched\n", n_in, ws_size, (size_t)WS_END); grid = -1; return; }
        int dev = 0, cus = 0, per_cu = 0;
        if (hipGetDevice(&dev) != hipSuccess || hipDeviceGetAttribute(&cus, hipDeviceAttributeMultiprocessorCount, dev) != hipSuccess) { grid = -1; return; }
        if (hipFuncSetAttribute((const void*)mk_fwd, hipFuncAttributeMaxDynamicSharedMemorySize, LDS_BYTES) != hipSuccess) { fprintf(stderr, "kernel_launch: hipFuncSetAttribute failed\n"); grid = -1; return; }
        if (hipOccupancyMaxActiveBlocksPerMultiprocessor(&per_cu, (const void*)mk_fwd, NTHR, LDS_BYTES) != hipSuccess || per_cu < 1) fprintf(stderr, "kernel_launch: occupancy query reports %d\n", per_cu);
        (void)hipGetLastError();
        grid = cus;
    }
    if (grid < 0) return;
    if (hipMemsetAsync((char*)d_ws + WS_CTL, 0, CTL_ZERO_BYTES, stream) != hipSuccess) return;
    Args a{};
    for (int i = 0; i < 22; ++i) a.in[i] = (const float*)d_in[i];
    a.out = (float*)d_out; a.ws = (unsigned char*)d_ws;
#if MK_ONE_LAUNCH
    a.ph_lo = 0; a.ph_hi = NPHASE;
    hipLaunchKernelGGL(mk_fwd, dim3(grid), dim3(NTHR), LDS_BYTES, stream, a);
#else
    for (int p = 0; p < NPHASE; ++p) { a.ph_lo = p; a.ph_hi = p + 1; hipLaunchKernelGGL(mk_fwd, dim3(grid), dim3(NTHR), LDS_BYTES, stream, a); }
#endif
}
```

```cpp
#include <hip/hip_runtime.h>
#include <cstdio>
#include <cstdint>
namespace pg8 {
#define PG8_LAS __attribute__((address_space(3)))
typedef unsigned short bf16_t;
typedef short bf16x8 __attribute__((ext_vector_type(8)));
typedef float f32x4 __attribute__((ext_vector_type(4)));
typedef unsigned u32x4 __attribute__((ext_vector_type(4)));
constexpr int BM = 256, BK = 64, HALF = 128, HTB = HALF * BK * 2  , STAGE_BYTES = 8 * HTB, NXCD = 8, WGM = 8;

__host__ __device__ __forceinline__ int lds_byte(int r, int c) { const int st = (r >> 4) * 2 + (c >> 5), rr = r & 15, cc = c & 31, ob = rr * 64 + cc * 2; return st * 1024 + (ob ^ (((ob >> 9) & 1) << 5)); }
__host__ __device__ __forceinline__ void stage_rc(int b, int& R, int& C) { const int st = b / 1024, sb = b % 1024, swz = sb ^ (((sb >> 9) & 1) << 5); R = (st >> 1) * 16 + swz / 64; C = (st & 1) * 32 + (swz % 64) / 2; }
__host__ __device__ __forceinline__ int perm32(int rho) { const int n = rho >> 4, i = rho & 15; return 8 * (i >> 2) + 4 * n + (i & 3); }

struct Unit { int pm, pn; };
struct Gemm { const bf16_t* A; const bf16_t* Bt; int M, N, K; };

struct StaticOrder {
    int nM, nN, nwg, G, c;
    __host__ __device__ void init(int M, int N, int G_, int c_) { nM = M / BM; nN = N / BM; nwg = nM * nN; G = G_; c = c_; }
    __host__ __device__ bool next(int i, Unit& u) const {
        const long L = (long)i * G + c; if (L >= nwg) return false;
        int wgid = (int)L; { const int q = nwg / NXCD, r = nwg % NXCD, xcd = wgid % NXCD, off = wgid / NXCD; wgid = (xcd < r ? xcd * (q + 1) : r * (q + 1) + (xcd - r) * q) + off; }
        const int nig = WGM * nN, gid = wgid / nig, fm = gid * WGM, gsz = (nM - fm) < WGM ? (nM - fm) : WGM;
        u.pm = fm + ((wgid % nig) % gsz); u.pn = (wgid % nig) / gsz; return true;
    }
    __device__ __forceinline__ void a_ready(const Unit&) const {}
    __device__ __forceinline__ void done(const Unit&) const {}
};

__device__ __forceinline__ unsigned cvt_pk_bf16(float lo, float hi) { unsigned r; asm volatile("v_cvt_pk_bf16_f32 %0, %1, %2" : "=v"(r) : "v"(lo), "v"(hi)); return r; }
typedef float f32x2 __attribute__((ext_vector_type(2)));
constexpr float RMS_EPS = 1e-6f;
typedef unsigned long long stat_t;
__device__ __forceinline__ float rstd_from(stat_t s) { const float f = __builtin_fmaf((float)(unsigned)(s >> 32), 4294967296.0f, (float)(unsigned)s); return __builtin_amdgcn_rsqf(f * (1.0f / (4294967296.0f * 1024.0f)) + RMS_EPS); }
__device__ __forceinline__ float rstd_of(const stat_t* st, int row) { return rstd_from(st[row]); }
__device__ __forceinline__ void stat_add(stat_t* st, int row, float ss) { atomicAdd(st + row, (stat_t)(ss * 4294967296.0f)); }
__device__ __forceinline__ float fast_sigmoid(float x) { return __builtin_amdgcn_rcpf(1.0f + __builtin_amdgcn_exp2f(-1.4426950408889634f * x)); }
typedef unsigned u32x4e __attribute__((ext_vector_type(4)));
__device__ __forceinline__ float bflo(unsigned w) { return __builtin_bit_cast(float, w << 16); }
__device__ __forceinline__ float bfhi(unsigned w) { return __builtin_bit_cast(float, w & 0xffff0000u); }

struct EpiSwiGLU {
    static constexpr bool PERM = true, AFTER_DRAIN = false;
    bf16_t* O; int ldc; const stat_t* st;
    __device__ __forceinline__ void operator()(const f32x4 (&acc)[2][2][4][2], const Unit& u, int wr, int wc, int fr, int fq) const {
        const int row0 = u.pm * BM + wr * 64 + fr, col0 = u.pn * HALF + wc * 32 + 8 * fq;
        stat_t sv[8];
#pragma unroll
        for (int i = 0; i < 8; ++i) sv[i] = st[row0 + (i >> 2) * HALF + (i & 3) * 16];
        asm volatile("" ::: "memory");
#pragma unroll
        for (int ai = 0; ai < 2; ++ai)
#pragma unroll
            for (int m = 0; m < 4; ++m) {
                const int row = row0 + ai * HALF + m * 16; const float r = rstd_from(sv[ai * 4 + m]);
                const float cr = -1.4426950408889634f * r, r2 = r * r; float o[8];
#pragma unroll
                for (int n = 0; n < 2; ++n)
#pragma unroll
                    for (int e = 0; e < 4; e += 2) { const f32x2 g2 = (f32x2){acc[ai][0][m][n][e], acc[ai][0][m][n][e + 1]}, u2 = (f32x2){acc[ai][1][m][n][e], acc[ai][1][m][n][e + 1]};
                        const f32x2 t = g2 * cr; f32x2 ex; ex.x = __builtin_amdgcn_exp2f(t.x); ex.y = __builtin_amdgcn_exp2f(t.y); const f32x2 d = ex + 1.0f;
                        f32x2 s; s.x = __builtin_amdgcn_rcpf(d.x); s.y = __builtin_amdgcn_rcpf(d.y); const f32x2 res = (g2 * u2) * (s * r2); o[n * 4 + e] = res.x; o[n * 4 + e + 1] = res.y; }
                u32x4e w; w.x = cvt_pk_bf16(o[0], o[1]); w.y = cvt_pk_bf16(o[2], o[3]); w.z = cvt_pk_bf16(o[4], o[5]); w.w = cvt_pk_bf16(o[6], o[7]);
                *(u32x4e*)(O + (size_t)row * ldc + col0) = w; }
    }
};
struct EpiRes {
    static constexpr bool PERM = true, AFTER_DRAIN = false;
    bf16_t* hb; stat_t* sto; float scale;
    __device__ __forceinline__ void operator()(const f32x4 (&acc)[2][2][4][2], const Unit& u, int wr, int wc, int fr, int fq) const {
        const int row0 = u.pm * BM + wr * 64 + fr, col0 = u.pn * BM + wc * 32 + 8 * fq;
#pragma unroll
        for (int ai = 0; ai < 2; ++ai) {
            u32x4e pre[4][2];
#pragma unroll
            for (int m = 0; m < 4; ++m)
#pragma unroll
                for (int bj = 0; bj < 2; ++bj) pre[m][bj] = *(const u32x4e*)(hb + (size_t)(row0 + ai * HALF + m * 16) * 1024 + col0 + bj * HALF);
            asm volatile("" ::: "memory");
#pragma unroll
            for (int m = 0; m < 4; ++m) {
                const int row = row0 + ai * HALF + m * 16; float ss = 0.f;
#pragma unroll
                for (int bj = 0; bj < 2; ++bj) {
                    const size_t off = (size_t)row * 1024 + col0 + bj * HALF;
                    const u32x4e bw = pre[m][bj];
                    const f32x4 b0 = (f32x4){bflo(bw.x), bfhi(bw.x), bflo(bw.y), bfhi(bw.y)}, b1 = (f32x4){bflo(bw.z), bfhi(bw.z), bflo(bw.w), bfhi(bw.w)};
                    const f32x4 v0 = b0 + acc[ai][bj][m][0] * scale, v1 = b1 + acc[ai][bj][m][1] * scale;
                    u32x4e w; w.x = cvt_pk_bf16(v0[0], v0[1]); w.y = cvt_pk_bf16(v0[2], v0[3]); w.z = cvt_pk_bf16(v1[0], v1[1]); w.w = cvt_pk_bf16(v1[2], v1[3]);
                    *(u32x4e*)(hb + off) = w;
                    ss += (v0[0] * v0[0] + v0[1] * v0[1]) + (v0[2] * v0[2] + v0[3] * v0[3]) + (v1[0] * v1[0] + v1[1] * v1[1]) + (v1[2] * v1[2] + v1[3] * v1[3]); }
                ss += __shfl_xor(ss, 16); ss += __shfl_xor(ss, 32);
                if (fq == 0) stat_add(sto, row, ss); } }
    }
};
struct EpiGluRes {
    static constexpr bool PERM = true, AFTER_DRAIN = false;
    bf16_t* hb; stat_t* sto;
    __device__ __forceinline__ void operator()(const f32x4 (&acc)[2][2][4][2], const Unit& u, int wr, int wc, int fr, int fq) const {
        const int row0 = u.pm * BM + wr * 64 + fr, col0 = u.pn * HALF + wc * 32 + 8 * fq;
        u32x4e pre[8];
#pragma unroll
        for (int i = 0; i < 8; ++i) pre[i] = *(const u32x4e*)(hb + (size_t)(row0 + (i >> 2) * HALF + (i & 3) * 16) * 1024 + col0);
        asm volatile("" ::: "memory");
#pragma unroll
        for (int ai = 0; ai < 2; ++ai)
#pragma unroll
            for (int m = 0; m < 4; ++m) {
                const int row = row0 + ai * HALF + m * 16; const size_t off = (size_t)row * 1024 + col0;
                const u32x4e bw = pre[ai * 4 + m];
                const f32x4 b0 = (f32x4){bflo(bw.x), bfhi(bw.x), bflo(bw.y), bfhi(bw.y)}, b1 = (f32x4){bflo(bw.z), bfhi(bw.z), bflo(bw.w), bfhi(bw.w)};
                f32x4 v0, v1;
#pragma unroll
                for (int e = 0; e < 4; ++e) { v0[e] = b0[e] + acc[ai][0][m][0][e] * fast_sigmoid(acc[ai][1][m][0][e]); v1[e] = b1[e] + acc[ai][0][m][1][e] * fast_sigmoid(acc[ai][1][m][1][e]); }
                u32x4e w; w.x = cvt_pk_bf16(v0[0], v0[1]); w.y = cvt_pk_bf16(v0[2], v0[3]); w.z = cvt_pk_bf16(v1[0], v1[1]); w.w = cvt_pk_bf16(v1[2], v1[3]);
                *(u32x4e*)(hb + off) = w;
                float ss = (v0[0] * v0[0] + v0[1] * v0[1]) + (v0[2] * v0[2] + v0[3] * v0[3]) + (v1[0] * v1[0] + v1[1] * v1[1]) + (v1[2] * v1[2] + v1[3] * v1[3]);
                ss += __shfl_xor(ss, 16); ss += __shfl_xor(ss, 32);
                if (fq == 0) stat_add(sto, row, ss); }
    }
};
template <bool KMEAN> struct EpiRowScale {
    static constexpr bool PERM = true, AFTER_DRAIN = false;
    bf16_t* O0; bf16_t* O1; const stat_t* st; float mul; float* kmp;
    __device__ __forceinline__ void operator()(const f32x4 (&acc)[2][2][4][2], const Unit& u, int wr, int wc, int fr, int fq) const {
        const int row0 = u.pm * BM + wr * 64 + fr, t = u.pn >> 2, col0 = (u.pn & 3) * BM + wc * 32 + 8 * fq;
        bf16_t* O = t ? O1 : O0;
        float cs[2][8];
#pragma unroll
        for (int bj = 0; bj < 2; ++bj)
#pragma unroll
            for (int j = 0; j < 8; ++j) cs[bj][j] = 0.f;
        stat_t sv[8];
#pragma unroll
        for (int i = 0; i < 8; ++i) sv[i] = st[row0 + (i >> 2) * HALF + (i & 3) * 16];
        asm volatile("" ::: "memory");
#pragma unroll
        for (int ai = 0; ai < 2; ++ai)
#pragma unroll
            for (int m = 0; m < 4; ++m) {
                const int row = row0 + ai * HALF + m * 16; const float r = rstd_from(sv[ai * 4 + m]) * mul;
#pragma unroll
                for (int bj = 0; bj < 2; ++bj) {
                    const f32x4 v0 = acc[ai][bj][m][0] * r, v1 = acc[ai][bj][m][1] * r;
                    u32x4e w; w.x = cvt_pk_bf16(v0[0], v0[1]); w.y = cvt_pk_bf16(v0[2], v0[3]); w.z = cvt_pk_bf16(v1[0], v1[1]); w.w = cvt_pk_bf16(v1[2], v1[3]);
                    *(u32x4e*)(O + (size_t)row * 1024 + col0 + bj * HALF) = w;
                    if (KMEAN) {
#pragma unroll
                        for (int e = 0; e < 4; ++e) { cs[bj][e] += v0[e]; cs[bj][4 + e] += v1[e]; } } } }
        if (KMEAN) {
            if (t == 0) {
#pragma unroll
                for (int bj = 0; bj < 2; ++bj)
#pragma unroll
                    for (int j = 0; j < 8; ++j) { float s = cs[bj][j]; s += __shfl_xor(s, 1); s += __shfl_xor(s, 2); s += __shfl_xor(s, 4); s += __shfl_xor(s, 8); cs[bj][j] = s; }
                if (fr == 0) {
#pragma unroll
                    for (int bj = 0; bj < 2; ++bj) { float* p = kmp + ((size_t)wr * 64 + u.pm) * 1024 + col0 + bj * HALF;
                        *(f32x4*)p = (f32x4){cs[bj][0], cs[bj][1], cs[bj][2], cs[bj][3]}; *(f32x4*)(p + 4) = (f32x4){cs[bj][4], cs[bj][5], cs[bj][6], cs[bj][7]}; } } } }
    }
};
template <class Epi, class Sched, bool ALIGN_EPI = false, bool SP2 = false>
__device__ __forceinline__ void gemm_phase(PG8_LAS unsigned char* lds, const Gemm g, const Sched& S, const Epi& E) {
    int tid_o = threadIdx.x; asm volatile("" : "+v"(tid_o));
    const int tid = tid_o, wid = __builtin_amdgcn_readfirstlane(tid >> 6), lane = tid & 63, wr = wid >> 2, wc = wid & 3, fr = lane & 15, fq = lane >> 4;
    const int K = g.K, nt = K / BK;
    unsigned voffA[2], voffB[2];
#pragma unroll
    for (int i = 0; i < 2; ++i) { int R, C; stage_rc(tid * 16 + i * 8192, R, C); const int Rb = Epi::PERM ? ((R & ~31) + perm32(R & 31)) : R;
        voffA[i] = (unsigned)(R * K + C) * 2u; voffB[i] = (unsigned)(Rb * K + C) * 2u; }
    const size_t kstep = (size_t)(BK * 2);
    const size_t hstep = (size_t)HALF * K * 2;
    const size_t tstep = 2 * hstep;
    const unsigned ldsw = (unsigned)wid * 1024u;
    const int aoff = lds_byte(wr * 64 + fr, fq * 8), boff = lds_byte(wc * 32 + fr, fq * 8);
#define PG8_SA(b, h) (((b) * 2 + (h)) * HTB)
#define PG8_SB(b, h) ((4 + (b) * 2 + (h)) * HTB)
#define PG8_STAGE(bufoff, gbase, voff) do { _Pragma("unroll") for (int _i = 0; _i < 2; ++_i) \
        __builtin_amdgcn_global_load_lds((const unsigned*)((const char*)(gbase) + (voff)[_i]), (PG8_LAS unsigned*)(lds + (bufoff) + ldsw + _i * 8192), 16, 0, 0); } while (0)
#define PG8_LDA(dst, b, h) do { _Pragma("unroll") for (int m = 0; m < 4; ++m) _Pragma("unroll") for (int k = 0; k < 2; ++k) dst[m][k] = *(const PG8_LAS bf16x8*)(lds + PG8_SA(b, h) + aoff + m * 2048 + k * 1024); } while (0)
#define PG8_LDB(dst, b, h) do { _Pragma("unroll") for (int n = 0; n < 2; ++n) _Pragma("unroll") for (int k = 0; k < 2; ++k) dst[n][k] = *(const PG8_LAS bf16x8*)(lds + PG8_SB(b, h) + boff + n * 2048 + k * 1024); } while (0)
#define PG8_MMA(ai, bj, At, Bt) do { __builtin_amdgcn_s_setprio(1); _Pragma("unroll") for (int m = 0; m < 4; ++m) _Pragma("unroll") for (int n = 0; n < 2; ++n) _Pragma("unroll") for (int k = 0; k < 2; ++k) \
        acc[ai][bj][m][n] = __builtin_amdgcn_mfma_f32_16x16x32_bf16(Bt[n][k], At[m][k], acc[ai][bj][m][n], 0, 0, 0); __builtin_amdgcn_s_setprio(0); } while (0)
#define PG8_WAIT_V(n) asm volatile("s_waitcnt vmcnt(" #n ")" ::: "memory")
#define PG8_WAIT_L(n) asm volatile("s_waitcnt lgkmcnt(" #n ")" ::: "memory")
#define PG8_BAR __builtin_amdgcn_s_barrier()
#define PG8_SCHED __builtin_amdgcn_sched_barrier(0)
    Unit cur, nxt; int ui = 0;
    if (!S.next(0, cur)) return;
    f32x4 acc[2][2][4][2];
#pragma unroll
    for (int a = 0; a < 2; ++a)
#pragma unroll
        for (int b = 0; b < 2; ++b)
#pragma unroll
            for (int m = 0; m < 4; ++m)
#pragma unroll
                for (int n = 0; n < 2; ++n) acc[a][b][m][n] = (f32x4){0.f, 0.f, 0.f, 0.f};
    bf16x8 At[4][2], B0[2][2], B1[2][2];
    const char* cA = (const char*)g.A + (size_t)cur.pm * tstep; const char* cB = (const char*)g.Bt + (size_t)cur.pn * tstep;
    S.a_ready(cur);
    if constexpr (SP2) {
        PG8_STAGE(PG8_SB(0, 0), cB, voffB); PG8_STAGE(PG8_SB(0, 1), cB + hstep, voffB); PG8_STAGE(PG8_SA(0, 0), cA, voffA); PG8_STAGE(PG8_SA(0, 1), cA + hstep, voffA);
        if (wr == 1) PG8_BAR;
        PG8_WAIT_V(2); PG8_BAR;
        PG8_STAGE(PG8_SB(1, 0), cB + kstep, voffB); PG8_STAGE(PG8_SA(1, 0), cA + kstep, voffA); PG8_STAGE(PG8_SB(1, 1), cB + hstep + kstep, voffB);
        PG8_WAIT_V(6); PG8_BAR;
    } else {
        PG8_STAGE(PG8_SB(0, 0), cB, voffB); PG8_STAGE(PG8_SA(0, 0), cA, voffA); PG8_STAGE(PG8_SB(0, 1), cB + hstep, voffB); PG8_STAGE(PG8_SA(0, 1), cA + hstep, voffA);
        if (wr == 1) PG8_BAR;
        PG8_WAIT_V(4); PG8_BAR;
        PG8_STAGE(PG8_SB(1, 0), cB + kstep, voffB); PG8_STAGE(PG8_SA(1, 0), cA + kstep, voffA); PG8_STAGE(PG8_SB(1, 1), cB + hstep + kstep, voffB);
        PG8_WAIT_V(6); PG8_BAR;
    }
    for (;;) {
        const bool has_next = S.next(ui + 1, nxt);
        const char* nA = has_next ? (const char*)g.A + (size_t)nxt.pm * tstep : cA; const char* nB = has_next ? (const char*)g.Bt + (size_t)nxt.pn * tstep : cB;
        for (int t = 0; t < nt; t += 2) {
            const bool last = (t == nt - 2);
            const char* a1 = cA + (size_t)(t + 1) * kstep;
            const char* a2 = last ? nA : cA + (size_t)(t + 2) * kstep; const char* b2 = last ? nB : cB + (size_t)(t + 2) * kstep;
            const char* a3 = a2 + kstep; const char* b3 = b2 + kstep;
            if (last && has_next) S.a_ready(nxt);
            if constexpr (SP2) {
            PG8_LDB(B0, 0, 0); PG8_LDB(B1, 0, 1); PG8_SCHED; PG8_LDA(At, 0, 0); PG8_STAGE(PG8_SA(1, 1), a1 + hstep, voffA);
            PG8_WAIT_V(8); PG8_WAIT_L(0); PG8_BAR; PG8_MMA(0, 0, At, B0); PG8_MMA(0, 1, At, B1); PG8_BAR; PG8_SCHED;
            PG8_LDA(At, 0, 1); PG8_STAGE(PG8_SB(0, 0), b2, voffB); PG8_STAGE(PG8_SB(0, 1), b2 + hstep, voffB); PG8_STAGE(PG8_SA(0, 0), a2, voffA);
            PG8_WAIT_V(8); PG8_WAIT_L(0); PG8_BAR; PG8_MMA(1, 0, At, B0); PG8_MMA(1, 1, At, B1); PG8_BAR; PG8_SCHED;
            PG8_LDB(B0, 1, 0); PG8_LDB(B1, 1, 1); PG8_SCHED; PG8_LDA(At, 1, 0); PG8_STAGE(PG8_SA(0, 1), a2 + hstep, voffA);
            PG8_WAIT_V(8); PG8_WAIT_L(0); PG8_BAR; PG8_MMA(0, 0, At, B0); PG8_MMA(0, 1, At, B1); PG8_BAR; PG8_SCHED;
            PG8_LDA(At, 1, 1); PG8_STAGE(PG8_SB(1, 0), b3, voffB); PG8_STAGE(PG8_SB(1, 1), b3 + hstep, voffB); PG8_STAGE(PG8_SA(1, 0), a3, voffA);
            PG8_WAIT_V(8); PG8_WAIT_L(0); PG8_BAR; PG8_MMA(1, 0, At, B0); PG8_MMA(1, 1, At, B1); PG8_BAR; PG8_SCHED;
            } else {
            PG8_LDB(B0, 0, 0); PG8_SCHED; PG8_LDA(At, 0, 0); PG8_STAGE(PG8_SA(1, 1), a1 + hstep, voffA);
            PG8_WAIT_L(8); PG8_BAR; PG8_WAIT_L(0); PG8_MMA(0, 0, At, B0); PG8_BAR; PG8_SCHED;
            PG8_LDB(B1, 0, 1); PG8_STAGE(PG8_SB(0, 0), b2, voffB);
            PG8_BAR; PG8_WAIT_L(0); PG8_MMA(0, 1, At, B1); PG8_BAR;
            PG8_LDA(At, 0, 1); PG8_STAGE(PG8_SA(0, 0), a2, voffA);
            PG8_BAR; PG8_WAIT_L(0); PG8_MMA(1, 0, At, B0); PG8_BAR; PG8_SCHED;
            PG8_STAGE(PG8_SB(0, 1), b2 + hstep, voffB);
            PG8_WAIT_V(6); PG8_BAR; PG8_MMA(1, 1, At, B1); PG8_BAR;
            PG8_LDB(B0, 1, 0); PG8_SCHED; PG8_LDA(At, 1, 0); PG8_STAGE(PG8_SA(0, 1), a2 + hstep, voffA);
            PG8_WAIT_L(8); PG8_BAR; PG8_WAIT_L(0); PG8_MMA(0, 0, At, B0); PG8_BAR; PG8_SCHED;
            PG8_LDB(B1, 1, 1); PG8_STAGE(PG8_SB(1, 0), b3, voffB);
            PG8_BAR; PG8_WAIT_L(0); PG8_MMA(0, 1, At, B1); PG8_BAR;
            PG8_LDA(At, 1, 1); PG8_STAGE(PG8_SA(1, 0), a3, voffA);
            PG8_BAR; PG8_WAIT_L(0); PG8_MMA(1, 0, At, B0); PG8_BAR; PG8_SCHED;
            PG8_STAGE(PG8_SB(1, 1), b3 + hstep, voffB);
            PG8_WAIT_V(6); PG8_BAR; PG8_MMA(1, 1, At, B1); PG8_BAR;
            }
        }
        if constexpr (ALIGN_EPI) { if (wr == 0) PG8_BAR; }
        if constexpr (!Epi::AFTER_DRAIN) { E(acc, cur, wr, wc, fr, fq); S.done(cur); }
        if (!has_next) break;
#pragma unroll
        for (int a = 0; a < 2; ++a)
#pragma unroll
            for (int b = 0; b < 2; ++b)
#pragma unroll
                for (int m = 0; m < 4; ++m)
#pragma unroll
                    for (int n = 0; n < 2; ++n) acc[a][b][m][n] = (f32x4){0.f, 0.f, 0.f, 0.f};
        cur = nxt; cA = nA; cB = nB; ++ui;
        if constexpr (ALIGN_EPI) { if (wr == 1) PG8_BAR; }
    }
    PG8_WAIT_V(0);
    if constexpr (!ALIGN_EPI) { if (wr == 0) PG8_BAR; }
    PG8_BAR;
    if constexpr (Epi::AFTER_DRAIN) { E.fused(acc, cur, wr, wc, fr, fq, lds, wid, lane); S.done(cur); }
#undef PG8_SA
#undef PG8_SB
#undef PG8_STAGE
#undef PG8_LDA
#undef PG8_LDB
#undef PG8_MMA
#undef PG8_WAIT_V
#undef PG8_WAIT_L
#undef PG8_BAR
#undef PG8_SCHED
}
}

constexpr int NWAVES = 8, NTHR = NWAVES * 64;
constexpr int BATCH = 8, SEQ = 2048, DM = 1024, DEPTH = 4, NA = 2, NBL = 2, SG = 64, SGC = 16, SP = 64, NH = 16, HD = 64, MBLK = 256, NBLK = SEQ / MBLK, DFF = 2816;
constexpr int M = BATCH * SEQ;
constexpr float C2 = 0.125f * 1.4426950408889634f;
constexpr size_t MiB = 1u << 20;
constexpr size_t WS_CTL = 0, CTL_ZERO_BYTES = 3 * MiB;
constexpr size_t WS_STATS = 1 * MiB;
constexpr size_t WS_L16 = 3 * MiB + 512 * 1024, WS_DG = WS_L16 + 64 * 1024;
constexpr size_t WS_KMP = 3 * MiB;
constexpr size_t WS_WIN = 4 * MiB, WIN_BYTES = (size_t)2 * DFF * DM * 2;
constexpr size_t WS_WOUT = WS_WIN + 8 * WIN_BYTES, WOUT_BYTES = (size_t)DM * DFF * 2;
constexpr size_t WS_WGLU = WS_WOUT + 8 * WOUT_BYTES, WGLU_BYTES = (size_t)2 * DM * DM * 2;
constexpr size_t WS_WKV = WS_WGLU + 2 * WGLU_BYTES;
constexpr size_t WS_WQ = WS_WKV + 4 * MiB, WS_WO = WS_WQ + 4 * MiB;
constexpr size_t WS_HB = WS_WO + 4 * MiB;
constexpr size_t WS_ACT = WS_HB + 32 * MiB;
constexpr size_t WS_K = WS_ACT + 88 * MiB, WS_V = WS_K + 32 * MiB, WS_END = WS_V + 32 * MiB;
static_assert(WS_WIN + 8 * WIN_BYTES + 8 * WOUT_BYTES + 2 * WGLU_BYTES + 12 * MiB == WS_HB && WS_HB == 156 * MiB && WS_END == 340 * MiB, "d_ws map");
constexpr int CW_TMO = 0, CW_BAR = 4096;
constexpr int NPHASE = 28;
constexpr int RING_OFF = 0, RING_BYTES = 131072;
constexpr int LDSCTL_OFF = RING_BYTES, MISC_OFF = LDSCTL_OFF + 320;
constexpr int LDS_BYTES = 147456;
#define GAS __attribute__((address_space(1)))
#define LAS __attribute__((address_space(3)))
typedef unsigned short bf16;
typedef unsigned v4u __attribute__((ext_vector_type(4)));
typedef float f32x4 __attribute__((ext_vector_type(4)));
typedef short bf16x8 __attribute__((ext_vector_type(8)));
typedef GAS unsigned gu32;
typedef GAS unsigned long long gu64;
#define RLX_AGENT __ATOMIC_RELAXED, __HIP_MEMORY_SCOPE_AGENT
#define LDS_WAIT() asm volatile("s_waitcnt lgkmcnt(0)" ::: "memory")
#define VM_WAIT() asm volatile("s_waitcnt vmcnt(0)" ::: "memory")
__device__ __forceinline__ unsigned long long rt() { return __builtin_amdgcn_s_memrealtime(); }
__device__ __forceinline__ unsigned f2bf(float f) { unsigned u = __builtin_bit_cast(unsigned, f); return (u + 0x7fffu + ((u >> 16) & 1u)) >> 16; }
__device__ __forceinline__ unsigned pk2(float lo, float hi) { return f2bf(lo) | (f2bf(hi) << 16); }

#define XB_TMO      128
#define XB_XCNT(j)  (256  + 64 * (j))
#define XB_XSUB(j)  (1280 + 64 * (j))
#define XB_XGEN(j)  (2304 + 64 * (j))
#define XB_TOP      3328
#define XB_TOPGEN   3392
#define XCD_BAR_WORDS 3456
#define XB_SPIN_CAP (1u << 18)

__device__ __forceinline__ unsigned xb_ld(unsigned* p)              { return __hip_atomic_load(p, __ATOMIC_RELAXED, __HIP_MEMORY_SCOPE_AGENT); }
__device__ __forceinline__ unsigned xb_add(unsigned* p, unsigned v) { return __hip_atomic_fetch_add(p, v, __ATOMIC_RELAXED, __HIP_MEMORY_SCOPE_AGENT); }
__device__ __forceinline__ unsigned xb_xcc_id() { return (unsigned)__builtin_amdgcn_s_getreg((3 << 11) | 20) & 0xFu; }
#define XB_SPIN(cond, bar) do { unsigned _sp = 0; while (cond) { __builtin_amdgcn_s_sleep(1); \
    if ((++_sp & 255u) == 0u) { if (xb_ld(&(bar)[XB_TMO])) break; if (_sp > XB_SPIN_CAP) { atomicAdd(&(bar)[XB_TMO], 1u); break; } } } } while (0)

struct XcdBarrier {
    unsigned* bar; unsigned x;
    volatile LAS unsigned* st;
};

__device__ __forceinline__ XcdBarrier xcd_barrier_post(unsigned* bar, volatile LAS unsigned* st) {
    XcdBarrier b; b.bar = bar; b.x = xb_xcc_id(); b.st = st;
    if (threadIdx.x == 0) (void)xb_add(&bar[XB_XCNT(b.x)], 1u);
    return b;
}
__device__ __forceinline__ void xcd_barrier_complete(unsigned* bar, unsigned x, unsigned& nloc, unsigned& nx) {
    const unsigned G = gridDim.x * gridDim.y * gridDim.z;
    unsigned sum, cnt, mine, sp = 0u;
    for (;;) {
        sum = 0u; cnt = 0u; mine = 0u;
#pragma unroll
        for (unsigned j = 0; j < 16; ++j) { const unsigned c = xb_ld(&bar[XB_XCNT(j)]); sum += c; cnt += (c > 0u) ? 1u : 0u; mine = (j == x) ? c : mine; }
        if (sum == G) break;
        __builtin_amdgcn_s_sleep(1);
        if ((++sp & 255u) == 0u) { if (xb_ld(&bar[XB_TMO])) break; if (sp > XB_SPIN_CAP) { atomicAdd(&bar[XB_TMO], 1u); break; } }
    }
    nloc = mine > 0u ? mine : 1u; nx = cnt > 0u ? cnt : 1u;
}

__device__ __forceinline__ void xcd_barrier(const XcdBarrier& b) {
    asm volatile("s_waitcnt vmcnt(0)" ::: "memory");
    __syncthreads();
    if (threadIdx.x == 0) {
        unsigned* bar = b.bar;
        __builtin_amdgcn_s_waitcnt(0);
        unsigned nloc = b.st[0], nx = b.st[1];
        if (nloc == 0u) { xcd_barrier_complete(bar, b.x, nloc, nx); b.st[0] = nloc; b.st[1] = nx; }
        const unsigned old = xb_add(&bar[XB_XSUB(b.x)], 1u);
        const unsigned gen = old / nloc;
        if (old + 1u == (gen + 1u) * nloc) {
            __builtin_amdgcn_fence(__ATOMIC_RELEASE, "agent");
            asm volatile("s_waitcnt vmcnt(0)" ::: "memory");
            const unsigned og = xb_add(&bar[XB_TOP], 1u);
            const unsigned tg = og / nx;
            if (og + 1u == (tg + 1u) * nx) xb_add(&bar[XB_TOPGEN], 1u);
            else XB_SPIN(xb_ld(&bar[XB_TOPGEN]) == tg, bar);
            __builtin_amdgcn_fence(__ATOMIC_ACQUIRE, "agent");
            xb_add(&bar[XB_XGEN(b.x)], 1u);
            asm volatile("s_waitcnt vmcnt(0)" ::: "memory");
        } else {
            XB_SPIN(xb_ld(&bar[XB_XGEN(b.x)]) == gen, bar);
            __builtin_amdgcn_fence(__ATOMIC_ACQUIRE, "agent");
            asm volatile("s_waitcnt vmcnt(0)" ::: "memory");
        }
    }
    __syncthreads();
}

typedef unsigned v2u __attribute__((ext_vector_type(2)));
__device__ __forceinline__ float bf_lo(unsigned w) { return __builtin_bit_cast(float, w << 16); }
__device__ __forceinline__ float bf_hi(unsigned w) { return __builtin_bit_cast(float, w & 0xffff0000u); }
__device__ __forceinline__ float wave_sum(float v) {
#pragma unroll
    for (int o = 1; o < 64; o <<= 1) v += __shfl_xor(v, o);
    return v;
}
__device__ __forceinline__ void p0_transpose_item(const float* W, int ldw, int srccol0, const float* gain, bf16* WT, int K, int n0, int k0, LAS float* scr, int lane) {
    { const int kr = lane >> 3, c4 = (lane & 7) * 4; f32x4 v[8]; float gv[8];
#pragma unroll
      for (int i = 0; i < 8; ++i) { const int kk = kr + 8 * i; v[i] = *(const f32x4*)(W + (size_t)(k0 + kk) * ldw + srccol0 + c4); gv[i] = gain ? gain[k0 + kk] : 1.0f; }
#pragma unroll
      for (int i = 0; i < 8; ++i) { const int kk = kr + 8 * i; LAS float* d = scr + kk * 33 + c4; const f32x4 w = v[i] * gv[i]; d[0] = w.x; d[1] = w.y; d[2] = w.z; d[3] = w.w; } }
    LDS_WAIT(); asm volatile("" ::: "memory");
    const int c = lane & 7;
#pragma unroll
    for (int j = 0; j < 4; ++j) { const int n = (lane >> 3) + 8 * j; const LAS float* s = scr + (8 * c) * 33 + n;
        v4u o; o.x = pk2(s[0 * 33], s[1 * 33]); o.y = pk2(s[2 * 33], s[3 * 33]); o.z = pk2(s[4 * 33], s[5 * 33]); o.w = pk2(s[6 * 33], s[7 * 33]);
        *(v4u*)(WT + (size_t)(n0 + n) * K + k0 + 8 * c) = o; }
    LDS_WAIT(); asm volatile("" ::: "memory");
}
__device__ __forceinline__ int il_col(int n0, int Hn) { const int t = n0 >> 8, w = n0 & 255; return (w < 128) ? t * 128 + w : Hn + t * 128 + (w - 128); }

struct Args { const float* in[22]; float* out; unsigned char* ws; int ph_lo, ph_hi; };
__device__ __forceinline__ float gelu_tanh(float x) { const float t = 0.7978845608028654f * (x + 0.044715f * x * x * x); return x * __builtin_amdgcn_rcpf(1.0f + __builtin_amdgcn_exp2f(-2.0f * 1.4426950408889634f * t)); }
__device__ __forceinline__ float fma_asm(float a, float b, float c) { float d; asm("v_fma_f32 %0, %1, %2, %3" : "=v"(d) : "v"(a), "v"(b), "v"(c)); return d; }
__device__ __forceinline__ void sincos_f(float ang, float& s, float& c) {
    const float q = __builtin_rintf(ang * 0.63661977236758134308f);
    float r = __builtin_fmaf(-q, 1.5707855225e+00f, ang); r = __builtin_fmaf(-q, 1.0804334124e-05f, r); const float r2 = r * r;
    float sp = fma_asm(2.7557319223985893e-06f, r2, -1.9841269841269841e-04f); sp = fma_asm(sp, r2, 8.3333333333333332e-03f); sp = fma_asm(sp, r2, -1.6666666666666666e-01f); const float sr = fma_asm(r * r2, sp, r);
    float cp = fma_asm(2.4801587301587302e-05f, r2, -1.3888888888888889e-03f); cp = fma_asm(cp, r2, 4.1666666666666664e-02f); cp = fma_asm(cp, r2, -0.5f); const float cr = fma_asm(r2, cp, 1.0f);
    const int qi = ((int)q) & 3;
    s = (qi == 0) ? sr : (qi == 1) ? cr : (qi == 2) ? -sr : -cr; c = (qi == 0) ? cr : (qi == 1) ? -sr : (qi == 2) ? -cr : sr;
}
template <class T> __device__ __forceinline__ T* opq(T* p) { size_t z = 0; asm volatile("" : "+s"(z)); return (T*)((unsigned char*)p + z); }
namespace s5 {
typedef float f32x16 __attribute__((ext_vector_type(16)));
typedef short bf16x8s __attribute__((ext_vector_type(8)));
constexpr int UP = 264, XP = 136;
constexpr int LDS_U = 0, LDS_X = 128 * UP * 2, LDS_E = LDS_X + 128 * XP * 2, LDS_END = LDS_E + 4 * 64 * 8;
constexpr size_t MAT_ELEMS = 131072, CM_OFF = 32768;
__device__ __forceinline__ int crow(int r, int hi) { return (r & 3) + 8 * (r >> 2) + 4 * hi; }
__device__ __forceinline__ float partner(float v, int hi) { auto rr = __builtin_amdgcn_permlane32_swap(__float_as_uint(v), __float_as_uint(v), false, false); return __uint_as_float(hi ? rr[0] : rr[1]); }
template <bool STORE> __device__ __forceinline__ void scan_rg(float& xr, float& xi, const float l16r, const float l16i, const f32x16& sre, const f32x16& sim, const int rg, const int hi, LAS unsigned short* xrow  ) {
    float ar = xr, ai = xi, par[4], pai[4];
#pragma unroll
    for (int i = 0; i < 4; ++i) { par[i] = ar; pai[i] = ai; const float nr = l16r * ar - l16i * ai + sre[4 * rg + i], ni = l16r * ai + l16i * ar + sim[4 * rg + i]; ar = nr; ai = ni; }
    float br = partner(ar, hi), bi = partner(ai, hi), pbr[4], pbi[4];
#pragma unroll
    for (int i = 0; i < 4; ++i) { pbr[i] = br; pbi[i] = bi; const float nr = l16r * br - l16i * bi + sre[4 * rg + i], ni = l16r * bi + l16i * br + sim[4 * rg + i]; br = nr; bi = ni; }
    if (STORE) {
#pragma unroll
        for (int i = 0; i < 4; ++i) { const float vr = hi ? pbr[i] : par[i], vi = hi ? pbi[i] : pai[i]; xrow[i * XP] = (unsigned short)f2bf(vr); xrow[i * XP + 64] = (unsigned short)f2bf(vi); } }
    const float or_ = partner(br, hi), oi_ = partner(bi, hi);
    xr = hi ? br : or_; xi = hi ? bi : oi_;
}
template <int VAR> __device__ __forceinline__ void phase_s5(const Args& a, LAS unsigned char* lds, int layer, const pg8::stat_t* stats, int G) {
    int tid_o = threadIdx.x; asm volatile("" : "+v"(tid_o)); const int tid = tid_o, lane = tid & 63, wave = __builtin_amdgcn_readfirstlane(tid >> 6), r32 = lane & 31, hi = lane >> 5;
    unsigned char* ws = opq(a.ws);
    const bf16* mats = (const bf16*)(ws + WS_K) + (size_t)layer * SG * MAT_ELEMS;
    const float* L16 = (const float*)(ws + WS_L16) + layer * SG * SP * 2; const float* DG = (const float*)(ws + WS_DG) + layer * DM;
    const bf16* hbp = (const bf16*)(ws + WS_HB); bf16* z = (bf16*)(ws + WS_ACT);
    LAS unsigned short* U = (LAS unsigned short*)(lds + LDS_U); LAS unsigned short* X = (LAS unsigned short*)(lds + LDS_X); LAS float* EX = (LAS float*)(lds + LDS_E);
    for (int u = blockIdx.x; u < BATCH * SG; u += G) {
        int b = u >> 6, g = u & 63;
        if (G == 256) { const int c = u & 255, w = (u >> 8) * 32 + (c >> 3); g = (c & 7) * 8 + (w & 7); b = w >> 3; }
        const bf16* BC = mats + (size_t)g * MAT_ELEMS; const bf16* CM = BC + CM_OFF;
        { v4u hw[8]; pg8::stat_t sv[8];
#pragma unroll
          for (int i = 0; i < 8; ++i) { const int idx = i * NTHR + tid, t = idx >> 1, j8 = (idx & 1) * 8; const int row = b * SEQ + t; hw[i] = *(const v4u*)(hbp + (size_t)row * DM + g * SGC + j8); sv[i] = stats[row]; }
#pragma unroll
          for (int i = 0; i < 8; ++i) { const int idx = i * NTHR + tid, t = idx >> 1, j8 = (idx & 1) * 8; const float r = pg8::rstd_from(sv[i]); v4u w;
            w.x = pk2(bf_lo(hw[i].x) * r, bf_hi(hw[i].x) * r); w.y = pk2(bf_lo(hw[i].y) * r, bf_hi(hw[i].y) * r); w.z = pk2(bf_lo(hw[i].z) * r, bf_hi(hw[i].z) * r); w.w = pk2(bf_lo(hw[i].w) * r, bf_hi(hw[i].w) * r);
            *(LAS v4u*)(U + (t >> 4) * UP + (t & 15) * 16 + j8) = w; } }
        const int st = wave & 1, q = wave >> 1; f32x16 sre, sim;
#pragma unroll
        for (int r = 0; r < 16; ++r) { sre[r] = 0.f; sim[r] = 0.f; }
        { const bf16* bcr = BC + (size_t)(32 * st + r32) * 256 + 8 * hi; const bf16* bci = bcr + 64 * 256; const LAS unsigned short* ua = U + (32 * q + r32) * UP + 8 * hi;
          bf16x8s b0[16], b1[16];
#pragma unroll
          for (int ks = 0; ks < 16; ++ks) { b0[ks] = *(const bf16x8s*)(bcr + 16 * ks); b1[ks] = *(const bf16x8s*)(bci + 16 * ks); }
          __syncthreads();
#pragma unroll
          for (int ks = 0; ks < 16; ++ks) { const bf16x8s av = *(const LAS bf16x8s*)(ua + 16 * ks);
              sre = __builtin_amdgcn_mfma_f32_32x32x16_bf16(av, b0[ks], sre, 0, 0, 0); sim = __builtin_amdgcn_mfma_f32_32x32x16_bf16(av, b1[ks], sim, 0, 0, 0); } }
        const int Rs = wave < 4 ? wave : 7 - wave, Rl = 7 - Rs, atS = wave < 4 ? 0 : 2, atL = 2 - atS;
        const bf16* cmS = CM + (size_t)(32 * Rs + r32) * 384 + 8 * hi; const bf16* cmL = CM + (size_t)(32 * Rl + r32) * 384 + 8 * hi;
        bf16x8s cfS[16];
#pragma unroll
        for (int ks = 0; ks < 16; ++ks) cfS[ks] = *(const bf16x8s*)(cmS + 16 * ks);
        const f32x4 dg0 = *(const f32x4*)(DG + g * SGC + 4 * hi), dg1 = *(const f32x4*)(DG + g * SGC + 8 + 4 * hi);
        const int p = 32 * st + r32; const float l16r = L16[(g * SP + p) * 2], l16i = L16[(g * SP + p) * 2 + 1];
        float xr = 0.f, xi = 0.f;
#pragma unroll
        for (int rg = 0; rg < 4; ++rg) scan_rg<false>(xr, xi, l16r, l16i, sre, sim, rg, hi, nullptr);
        if (hi == 0) { EX[(q * 64 + p) * 2] = xr; EX[(q * 64 + p) * 2 + 1] = xi; }
        float Lr = l16r, Li = l16i;
#pragma unroll
        for (int s = 0; s < 5; ++s) { const float nr = Lr * Lr - Li * Li, ni = 2.0f * Lr * Li; Lr = nr; Li = ni; }
        __syncthreads();
        xr = 0.f; xi = 0.f;
        for (int qq = 0; qq < q; ++qq) { const float er = EX[(qq * 64 + p) * 2], ei = EX[(qq * 64 + p) * 2 + 1]; const float nr = Lr * xr - Li * xi + er, ni = Lr * xi + Li * xr + ei; xr = nr; xi = ni; }
#pragma unroll
        for (int rg = 0; rg < 4; ++rg) scan_rg<true>(xr, xi, l16r, l16i, sre, sim, rg, hi, X + (32 * q + crow(4 * rg, hi)) * XP + p);
        __syncthreads();
#define S5_JOB(R, at, NF, cf) do { f32x16 acc0, acc1; \
            _Pragma("unroll") for (int r = 0; r < 16; ++r) { acc0[r] = 0.f; acc1[r] = 0.f; } \
            const LAS unsigned short* xa = X + (32 * (at) + r32) * XP + 8 * hi; const LAS unsigned short* ua = U + (32 * (at) + r32) * UP + 8 * hi; \
            _Pragma("unroll") for (int ks = 0; ks < 8; ++ks) { const bf16x8s x0 = *(const LAS bf16x8s*)(xa + 16 * ks), x1 = *(const LAS bf16x8s*)(xa + 32 * XP + 16 * ks); \
                acc0 = __builtin_amdgcn_mfma_f32_32x32x16_bf16(cf[ks], x0, acc0, 0, 0, 0); acc1 = __builtin_amdgcn_mfma_f32_32x32x16_bf16(cf[ks], x1, acc1, 0, 0, 0); } \
            _Pragma("unroll") for (int sg = 0; sg < (NF) - 8; ++sg) { const bf16x8s u0 = *(const LAS bf16x8s*)(ua + 16 * sg), u1 = *(const LAS bf16x8s*)(ua + 32 * UP + 16 * sg); \
                acc0 = __builtin_amdgcn_mfma_f32_32x32x16_bf16(cf[8 + sg], u0, acc0, 0, 0, 0); acc1 = __builtin_amdgcn_mfma_f32_32x32x16_bf16(cf[8 + sg], u1, acc1, 0, 0, 0); } \
            _Pragma("unroll") for (int rt = 0; rt < 2; ++rt) { const int chunk = 32 * ((at) + rt) + r32; \
                _Pragma("unroll") for (int tp = 0; tp < 2; ++tp) { const int tau = 2 * (R) + tp; v2u zq[2]; \
                    _Pragma("unroll") for (int qh = 0; qh < 2; ++qh) { const int q4 = 2 * tp + qh, j0 = qh * 8 + 4 * hi; \
                        const v2u uw = *(const LAS v2u*)(U + chunk * UP + tau * 16 + j0); const f32x4 dg = qh ? dg1 : dg0; \
                        const float y0 = (rt ? acc1[4 * q4] : acc0[4 * q4]) + dg.x * bf_lo(uw.x), y1 = (rt ? acc1[4 * q4 + 1] : acc0[4 * q4 + 1]) + dg.y * bf_hi(uw.x); \
                        const float y2 = (rt ? acc1[4 * q4 + 2] : acc0[4 * q4 + 2]) + dg.z * bf_lo(uw.y), y3 = (rt ? acc1[4 * q4 + 3] : acc0[4 * q4 + 3]) + dg.w * bf_hi(uw.y); \
                        zq[qh].x = pk2(gelu_tanh(y0), gelu_tanh(y1)); zq[qh].y = pk2(gelu_tanh(y2), gelu_tanh(y3)); } \
                      \
                    { auto r0 = __builtin_amdgcn_permlane32_swap(zq[0].x, zq[1].x, false, false); auto r1 = __builtin_amdgcn_permlane32_swap(zq[0].y, zq[1].y, false, false); \
                      v4u zo; zo.x = r0[0]; zo.y = r1[0]; zo.z = r0[1]; zo.w = r1[1]; \
                      *(v4u*)(z + ((size_t)b * SEQ + 16 * chunk + tau) * DM + g * SGC + 8 * hi) = zo; } } } } while (0)
        { bf16x8s cfL[24];
#pragma unroll
          for (int ks = 0; ks < 24; ++ks) cfL[ks] = *(const bf16x8s*)(cmL + 16 * ks);
          S5_JOB(Rs, atS, 16, cfS);
          S5_JOB(Rl, atL, 24, cfL); }
#undef S5_JOB
        __syncthreads();
    }
}
__device__ __forceinline__ void s5_gen_item(const Args& a, LAS unsigned char* lds, int item) {
    int tid_o = threadIdx.x; asm volatile("" : "+v"(tid_o)); const int tid = tid_o;
    const int layer = item >> 7, g = (item >> 1) & 63, half = item & 1, lg = layer * SG + g;
    unsigned char* ws = opq(a.ws);
    LAS float* pw = (LAS float*)lds; LAS float* bb = pw + 17 * 128; LAS float* cc = bb + 2048; LAS float* kl = cc + 2048; LAS float* fz = kl + 4096;
    bf16* BC = (bf16*)(ws + WS_K) + ((size_t)layer * SG + g) * MAT_ELEMS; bf16* CM = BC + CM_OFF;
    if (tid < 64) { const int p = tid; const float dt = expf(a.in[15][lg]); const float ar = fminf(a.in[8][lg * SP + p], -1e-4f), ai = a.in[9][lg * SP + p];
        const float mag = expf(ar * dt); float sn, cn; sincos_f(ai * dt, sn, cn);
        const double dlr = (double)(mag * cn), dli = (double)(mag * sn), nr = dlr - 1.0, dar = (double)ar, dai = (double)ai, den = dar * dar + dai * dai;
        fz[2 * p] = (float)((nr * dar + dli * dai) / den); fz[2 * p + 1] = (float)((dli * dar - nr * dai) / den);
        double wr = 1.0, wi = 0.0;
        for (int k = 0; k <= 16; ++k) { pw[(k * 64 + p) * 2] = (float)wr; pw[(k * 64 + p) * 2 + 1] = (float)wi; const double t = wr * dlr - wi * dli; wi = wr * dli + wi * dlr; wr = t; }
    }
    __syncthreads();
    { const float* gain = a.in[4] + layer * DM + g * SGC;
      for (int i = tid; i < 1024; i += NTHR) { const int p = i >> 4, j = i & 15; const float fr = fz[2 * p], fi = fz[2 * p + 1]; const float br = a.in[10][((size_t)lg * SP + p) * SGC + j], bi = a.in[11][((size_t)lg * SP + p) * SGC + j], gn = gain[j];
          bb[i * 2] = (fr * br - fi * bi) * gn; bb[i * 2 + 1] = (fr * bi + fi * br) * gn; }
      for (int i = tid; i < 1024; i += NTHR) { cc[i * 2] = a.in[12][(size_t)lg * 1024 + i]; cc[i * 2 + 1] = a.in[13][(size_t)lg * 1024 + i]; }
      if (half == 0) { if (tid < 64) { float* L16 = (float*)(ws + WS_L16) + (size_t)lg * SP * 2; L16[2 * tid] = pw[(16 * 64 + tid) * 2]; L16[2 * tid + 1] = pw[(16 * 64 + tid) * 2 + 1]; }
          if (tid >= 64 && tid < 80) { const int j = tid - 64; ((float*)(ws + WS_DG))[layer * DM + g * SGC + j] = a.in[14][layer * DM + g * SGC + j] * gain[j]; } } }
    __syncthreads();
    { const int lag = tid >> 5, j = (tid >> 1) & 15, jh = (tid & 1) * 8; float acc[8];
#pragma unroll
      for (int i = 0; i < 8; ++i) acc[i] = 0.f;
      for (int p = 0; p < 64; ++p) { const float cr = cc[(j * 64 + p) * 2], ci = cc[(j * 64 + p) * 2 + 1], wr = pw[(lag * 64 + p) * 2], wi = pw[(lag * 64 + p) * 2 + 1]; const float tr = cr * wr - ci * wi, ti = cr * wi + ci * wr;
#pragma unroll
          for (int i = 0; i < 8; ++i) acc[i] += tr * bb[((p * 16) + jh + i) * 2] - ti * bb[((p * 16) + jh + i) * 2 + 1]; }
#pragma unroll
      for (int i = 0; i < 8; ++i) kl[(lag * 16 + j) * 16 + jh + i] = acc[i]; }
    __syncthreads();
    if (half == 0) {
        for (int ci = tid; ci < 4096; ci += NTHR) { const int s = ci >> 5, k0 = (ci & 31) * 8, sig = k0 >> 4, j0 = k0 & 15, p = s & 63, im = s >> 6; const float wr = pw[((15 - sig) * 64 + p) * 2], wi = pw[((15 - sig) * 64 + p) * 2 + 1]; float v[8];
#pragma unroll
            for (int e = 0; e < 8; ++e) { const float br = bb[(p * 16 + j0 + e) * 2], bi = bb[(p * 16 + j0 + e) * 2 + 1]; v[e] = im ? (wr * bi + wi * br) : (wr * br - wi * bi); }
            v4u o; o.x = pk2(v[0], v[1]); o.y = pk2(v[2], v[3]); o.z = pk2(v[4], v[5]); o.w = pk2(v[6], v[7]); *(v4u*)(BC + (size_t)s * 256 + k0) = o; } }
    for (int ci = tid; ci < 6144; ci += NTHR) { const int rl = ci / 48, k0 = (ci % 48) * 8, row = half * 128 + rl, tau = row >> 4, j = row & 15; float v[8];
        if (k0 < 128) { const int im = k0 >> 6, p0 = k0 & 63;
#pragma unroll
            for (int e = 0; e < 8; ++e) { const int p = p0 + e; const float cr = cc[(j * 64 + p) * 2], ci2 = cc[(j * 64 + p) * 2 + 1], wr = pw[((tau + 1) * 64 + p) * 2], wi = pw[((tau + 1) * 64 + p) * 2 + 1]; v[e] = im ? -(cr * wi + ci2 * wr) : (cr * wr - ci2 * wi); } }
        else { const int sig = (k0 - 128) >> 4, j0 = (k0 - 128) & 15; const int lag = tau - sig;
#pragma unroll
            for (int e = 0; e < 8; ++e) v[e] = (lag >= 0) ? kl[((lag < 0 ? 0 : lag) * 16 + j) * 16 + j0 + e] : 0.f; }
        v4u o; o.x = pk2(v[0], v[1]); o.y = pk2(v[2], v[3]); o.z = pk2(v[4], v[5]); o.w = pk2(v[6], v[7]); *(v4u*)(CM + (size_t)row * 384 + k0) = o; }
    __syncthreads();
}
}

constexpr int I_IN = (DM / 64) * (2 * DFF / 32), I_OUT = (DFF / 64) * (DM / 32), I_GLU = (DM / 64) * (2 * DM / 32), I_KV = I_GLU, I_SQ = (DM / 64) * (DM / 32);
constexpr int T_IN = 8 * I_IN, T_OUT = 8 * I_OUT, T_GLU = 2 * I_GLU, T_KV = I_KV, T_Q = 2 * I_SQ, T_O = 2 * I_SQ, NITEMS = T_IN + T_OUT + T_GLU + T_KV + T_Q + T_O;
constexpr int IT_OUT = T_IN, IT_GLU = IT_OUT + T_OUT, IT_KV = IT_GLU + T_GLU, IT_Q = IT_KV + T_KV, IT_O = IT_Q + T_Q;
__device__ __forceinline__ void convert_item(const Args& a, unsigned char* ws, int it, LAS float* scr, int lane) {
    int r = it;
    if (r < T_IN) { const int j = r / I_IN, q = r % I_IN, l = j >> 1, f = j & 1; const int nblk = 2 * DFF / 32, kb = q / nblk, nb = q % nblk, n0 = 32 * nb;
        p0_transpose_item(a.in[f ? 6 : 2] + (size_t)l * DM * 2 * DFF, 2 * DFF, il_col(n0, DFF), a.in[f ? 5 : 1] + l * DM, (bf16*)(ws + WS_WIN + (size_t)j * WIN_BYTES), DM, n0, 64 * kb, scr, lane); return; } r -= T_IN;
    if (r < T_OUT) { const int j = r / I_OUT, q = r % I_OUT, l = j >> 1, f = j & 1; const int nblk = DM / 32, kb = q / nblk, nb = q % nblk, n0 = 32 * nb;
        p0_transpose_item(a.in[f ? 7 : 3] + (size_t)l * DFF * DM, DM, n0, nullptr, (bf16*)(ws + WS_WOUT + (size_t)j * WOUT_BYTES), DFF, n0, 64 * kb, scr, lane); return; } r -= T_OUT;
    if (r < T_GLU) { const int l = r / I_GLU, q = r % I_GLU; const int nblk = 2 * DM / 32, kb = q / nblk, nb = q % nblk, n0 = 32 * nb;
        p0_transpose_item(a.in[16] + (size_t)l * DM * 2 * DM, 2 * DM, il_col(n0, DM), nullptr, (bf16*)(ws + WS_WGLU + (size_t)l * WGLU_BYTES), DM, n0, 64 * kb, scr, lane); return; } r -= T_GLU;
    if (r < T_KV) { const int q = r; const int nblk = 2 * DM / 32, kb = q / nblk, nb = q % nblk, n0 = 32 * nb;
        p0_transpose_item(a.in[18], 2 * DM, n0, a.in[17], (bf16*)(ws + WS_WKV), DM, n0, 64 * kb, scr, lane); return; } r -= T_KV;
    if (r < T_Q) { const int l = r / I_SQ, q = r % I_SQ; const int nblk = DM / 32, kb = q / nblk, nb = q % nblk, n0 = 32 * nb;
        p0_transpose_item(a.in[19] + (size_t)l * DM * DM, DM, n0, a.in[4] + (NA + l) * DM, (bf16*)(ws + WS_WQ + (size_t)l * 2 * MiB), DM, n0, 64 * kb, scr, lane); return; } r -= T_Q;
    { const int l = r / I_SQ, q = r % I_SQ; const int nblk = DM / 32, kb = q / nblk, nb = q % nblk, n0 = 32 * nb;
        p0_transpose_item(a.in[20] + (size_t)l * DM * DM, DM, n0, nullptr, (bf16*)(ws + WS_WO + (size_t)l * 2 * MiB), DM, n0, 64 * kb, scr, lane); }
}
__device__ __forceinline__ void convert_ranges(const Args& a, LAS unsigned char* lds, int worker, int nworkers, int lo0, int n0, int lo1, int n1, int lo2, int n2, int lo3, int n3) {
    int tid_o = threadIdx.x; asm volatile("" : "+v"(tid_o)); const int lane = tid_o & 63, wave = __builtin_amdgcn_readfirstlane(tid_o >> 6);
    LAS float* scr = (LAS float*)(lds + RING_OFF + wave * 16384); unsigned char* ws = opq(a.ws);
    int off = worker;
    for (; off < n0; off += nworkers) convert_item(a, ws, lo0 + off, scr, lane); off -= n0;
    for (; off < n1; off += nworkers) convert_item(a, ws, lo1 + off, scr, lane); off -= n1;
    for (; off < n2; off += nworkers) convert_item(a, ws, lo2 + off, scr, lane); off -= n2;
    for (; off < n3; off += nworkers) convert_item(a, ws, lo3 + off, scr, lane);
}
__device__ __forceinline__ void convert_tail_slot(const Args& a, LAS unsigned char* lds, int j, int worker, int nworkers) {
    if (j >= 7) return;
    int lo2 = 0, n2 = 0, lo3 = 0, n3 = 0;
    if (j == 0) { lo2 = IT_GLU; n2 = I_GLU; } else if (j == 1) { lo2 = IT_GLU + I_GLU; n2 = I_GLU; } else if (j == 2) { lo2 = IT_KV; n2 = I_KV; }
    else if (j == 3) { lo2 = IT_Q; n2 = I_SQ; lo3 = IT_O; n3 = I_SQ; } else if (j == 5) { lo2 = IT_Q + I_SQ; n2 = I_SQ; lo3 = IT_O + I_SQ; n3 = I_SQ; }
    convert_ranges(a, lds, worker, nworkers, (j + 1) * I_IN, I_IN, IT_OUT + (j + 1) * I_OUT, I_OUT, lo2, n2, lo3, n3);
}
__device__ __forceinline__ void phase_prologue(const Args& a, LAS unsigned char* lds, int vcu, int G) {
    int tid_o = threadIdx.x; asm volatile("" : "+v"(tid_o)); const int lane = tid_o & 63, wave = __builtin_amdgcn_readfirstlane(tid_o >> 6);
    for (int item = vcu; item < 2 * NA * SG; item += G) s5::s5_gen_item(a, lds + RING_OFF, item);
    const int gw = vcu * NWAVES + wave, NGW = G * NWAVES;
    unsigned char* ws = a.ws;
    if (G == 256) convert_ranges(a, lds, gw, NGW, 0, I_IN, IT_OUT, I_OUT, 0, 0, 0, 0);
    else convert_ranges(a, lds, gw, NGW, 0, NITEMS, 0, 0, 0, 0, 0, 0);
    const float* x = a.in[0]; bf16* hb = (bf16*)(ws + WS_HB); pg8::stat_t* st0 = (pg8::stat_t*)(ws + WS_STATS);
    for (int m = gw; m < M; m += 2 * NGW) {
        const bool two = (m + NGW < M); const int m2 = two ? m + NGW : m; f32x4 v[2][4];
#pragma unroll
        for (int j = 0; j < 4; ++j) { v[0][j] = ((const f32x4*)(x + (size_t)m * DM) + lane)[64 * j]; v[1][j] = ((const f32x4*)(x + (size_t)m2 * DM) + lane)[64 * j]; }
#pragma unroll
        for (int q = 0; q < 2; ++q) { if (q && !two) break; const int mm = q ? m2 : m; unsigned long long* o8 = (unsigned long long*)(hb + (size_t)mm * DM) + lane; float s = 0.f;
#pragma unroll
            for (int j = 0; j < 4; ++j) { const f32x4 w = v[q][j]; s += (w.x * w.x + w.y * w.y) + (w.z * w.z + w.w * w.w); o8[64 * j] = (unsigned long long)pk2(w.x, w.y) | ((unsigned long long)pk2(w.z, w.w) << 32); }
            s = wave_sum(s); if (lane == 0) st0[mm] = (pg8::stat_t)(s * 4294967296.0f); }
    }
}
__device__ __forceinline__ void phase_final(const Args& a, int vcu, int G) {
    int tid_o = threadIdx.x; asm volatile("" : "+v"(tid_o)); const int lane = tid_o & 63, wave = __builtin_amdgcn_readfirstlane(tid_o >> 6);
    const int gw = vcu * NWAVES + wave, NGW = G * NWAVES; const float* gn = a.in[21]; const bf16* hb = (const bf16*)(opq(a.ws) + WS_HB);
    f32x4 g[4];
#pragma unroll
    for (int j = 0; j < 2; ++j) { g[2 * j] = *(const f32x4*)(gn + 512 * j + 8 * lane); g[2 * j + 1] = *(const f32x4*)(gn + 512 * j + 8 * lane + 4); }
    for (int m0 = gw; m0 < M; m0 += 4 * NGW) {
        v4u w[4][2];
#pragma unroll
        for (int q = 0; q < 4; ++q) { const size_t m = (size_t)(m0 + q * NGW < M ? m0 + q * NGW : m0); w[q][0] = *(const v4u*)(hb + m * DM + 8 * lane); w[q][1] = *(const v4u*)(hb + m * DM + 512 + 8 * lane); }
#pragma unroll
        for (int q = 0; q < 4; ++q) { if (m0 + q * NGW >= M) break; const size_t m = (size_t)(m0 + q * NGW); const v4u w0 = w[q][0], w1 = w[q][1];
            f32x4 v[4]; v[0] = (f32x4){bf_lo(w0.x), bf_hi(w0.x), bf_lo(w0.y), bf_hi(w0.y)}; v[1] = (f32x4){bf_lo(w0.z), bf_hi(w0.z), bf_lo(w0.w), bf_hi(w0.w)};
            v[2] = (f32x4){bf_lo(w1.x), bf_hi(w1.x), bf_lo(w1.y), bf_hi(w1.y)}; v[3] = (f32x4){bf_lo(w1.z), bf_hi(w1.z), bf_lo(w1.w), bf_hi(w1.w)};
            float s = 0.f;
#pragma unroll
            for (int j = 0; j < 4; ++j) s += (v[j].x * v[j].x + v[j].y * v[j].y) + (v[j].z * v[j].z + v[j].w * v[j].w);
            const float r = rsqrtf(wave_sum(s) * (1.0f / DM) + 1e-6f);
            float* o = a.out + m * DM + 8 * lane;
            *(f32x4*)(o) = v[0] * r * g[0]; *(f32x4*)(o + 4) = v[1] * r * g[1]; *(f32x4*)(o + 512) = v[2] * r * g[2]; *(f32x4*)(o + 516) = v[3] * r * g[3]; }
    }
}
#include <hip/hip_bf16.h>
#include <cmath>
namespace attn_body {
using bf16=__hip_bfloat16;
using bf16x8=__attribute__((ext_vector_type(8)))short;
using s16x4=__attribute__((ext_vector_type(4)))short;
using f32x16=__attribute__((ext_vector_type(16)))float;
using u32x4=__attribute__((ext_vector_type(4)))unsigned;
constexpr int BATCH=8,NHEAD=16,SEQ=2048,D=64,DM=NHEAD*D;
constexpr int NW=8,QBLK=32,QB=QBLK*NW,KVBLK=64,NQB=SEQ/QB;
constexpr int ATTN_PITCH=DM, ATTN_UNIT_ROWS=QB;
__device__ __forceinline__ int crow(int r,int hi){return (r&3)+8*(r>>2)+4*hi;}
#define SBAR() __builtin_amdgcn_sched_barrier(0)
__device__ __forceinline__ void cmask(f32x16&p0,f32x16&p1,int jb,int qrel,int hi){
  const float NEG=-INFINITY; int kb=64*jb+4*hi;
  #pragma unroll
  for(int r=0;r<16;++r){int kv=kb+(r&3)+8*(r>>2); if(kv>qrel)p0[r]=NEG; if(kv+32>qrel)p1[r]=NEG;}
}

typedef float f32x4_t __attribute__((ext_vector_type(4)));
__device__ __forceinline__ float bfu(short x){ return __uint_as_float(((unsigned)(unsigned short)x)<<16); }
constexpr int NSLOT=3, SLOTB=8192;
constexpr int LDS_K=0, LDS_V=NSLOT*SLOTB, LDS_WS=2*NSLOT*SLOTB, LDS_OST=LDS_WS+NW*64*4, LDS_KM=LDS_OST+NW*4096, LDS_BYTES=LDS_KM+8*64*4;
constexpr float C2=0.125f*1.4426950408889634f;
__device__ __forceinline__ void glds16(const void*gsrc,unsigned lds_dst){unsigned keep;
  asm volatile("s_mov_b32 %0, m0\n\ts_mov_b32 m0, %2\n\ts_nop 0\n\tglobal_load_lds_dwordx4 %1, off\n\ts_mov_b32 m0, %0":"=&s"(keep):"v"(gsrc),"s"(lds_dst):"memory");}
__device__ __forceinline__ float max3f(float a,float b,float c){float r;asm("v_max3_f32 %0, %1, %2, %3":"=v"(r):"v"(a),"v"(b),"v"(c));return r;}
__device__ __forceinline__ float max2f(float a,float b){float r;asm("v_max_f32_e32 %0, %1, %2":"=v"(r):"v"(a),"v"(b));return r;}
__device__ __forceinline__ float fadd_s(float a,float b){float r;asm("v_add_f32_e32 %0, %1, %2":"=v"(r):"v"(a),"v"(b));return r;}
__device__ __forceinline__ float fsub_s(float a,float b){float r;asm("v_sub_f32_e32 %0, %1, %2":"=v"(r):"v"(a),"v"(b));return r;}
typedef float f32x2_t __attribute__((ext_vector_type(2))); typedef __bf16 bf16x2_t __attribute__((ext_vector_type(2)));
__device__ __forceinline__ unsigned cvtpk_s(float lo,float hi){f32x2_t v={lo,hi};bf16x2_t b=__builtin_convertvector(v,bf16x2_t);return __builtin_bit_cast(unsigned,b);}
#define WAIT_BAR(N) asm volatile("s_waitcnt vmcnt(" #N ") lgkmcnt(0)\n\ts_barrier":::"memory")

__device__ __forceinline__ void qkt(f32x16&p0,f32x16&p1,const char*Kslot,const bf16x8*qr,const f32x16&c0i,const f32x16&c1i,int r32,int hi){
  const char*kb=Kslot+hi*1024+r32*16;
  #pragma unroll
  for(int d0=0;d0<4;++d0){
    const bf16x8 b0=*reinterpret_cast<const bf16x8*>(kb+d0*2048);
    const bf16x8 b1=*reinterpret_cast<const bf16x8*>(kb+d0*2048+512);
    if(d0==0){p0=__builtin_amdgcn_mfma_f32_32x32x16_bf16(b0,qr[0],c0i,0,0,0);p1=__builtin_amdgcn_mfma_f32_32x32x16_bf16(b1,qr[0],c1i,0,0,0);}
    else{p0=__builtin_amdgcn_mfma_f32_32x32x16_bf16(b0,qr[d0],p0,0,0,0);p1=__builtin_amdgcn_mfma_f32_32x32x16_bf16(b1,qr[d0],p1,0,0,0);}}
}
typedef __attribute__((address_space(3))) const char* lds_cptr;
typedef short v4i16_t __attribute__((ext_vector_type(4)));
__device__ __forceinline__ void kload8(bf16x8*kf,lds_cptr kp){
  kf[0]=*(const __attribute__((address_space(3))) bf16x8*)(kp);      kf[1]=*(const __attribute__((address_space(3))) bf16x8*)(kp+512);
  kf[2]=*(const __attribute__((address_space(3))) bf16x8*)(kp+2048); kf[3]=*(const __attribute__((address_space(3))) bf16x8*)(kp+2560);
  kf[4]=*(const __attribute__((address_space(3))) bf16x8*)(kp+4096); kf[5]=*(const __attribute__((address_space(3))) bf16x8*)(kp+4608);
  kf[6]=*(const __attribute__((address_space(3))) bf16x8*)(kp+6144); kf[7]=*(const __attribute__((address_space(3))) bf16x8*)(kp+6656);
}
__device__ __forceinline__ void kload2(bf16x8*kf,lds_cptr kp,int j){ kf[2*j]=*(const __attribute__((address_space(3))) bf16x8*)(kp+j*2048); kf[2*j+1]=*(const __attribute__((address_space(3))) bf16x8*)(kp+j*2048+512); }
__device__ __forceinline__ s16x4 vtr(lds_cptr p){ return __builtin_bit_cast(s16x4,__builtin_amdgcn_ds_read_tr16_b64_v4i16((__attribute__((address_space(3))) v4i16_t*)p)); }
__device__ __forceinline__ float rowmax(const f32x16&p0,const f32x16&p1){
  float a=max3f(p0[0],p0[1],p1[0]),b=max3f(p0[2],p0[3],p1[1]);a=max3f(a,p1[2],p1[3]);
  #pragma unroll
  for(int r=4;r<16;r+=4){a=max3f(a,p0[r],p0[r+1]);b=max3f(b,p0[r+2],p0[r+3]);a=max3f(a,p1[r],p1[r+1]);b=max3f(b,p1[r+2],p1[r+3]);}
  const float m=max2f(a,b);
  auto rr=__builtin_amdgcn_permlane32_swap(__float_as_uint(m),__float_as_uint(m),false,false);
  return max2f(__uint_as_float(rr[0]),__uint_as_float(rr[1]));
}
__device__ __forceinline__ void pv(f32x16*o,int vb,bf16x8 pa0,bf16x8 pa1,bf16x8 pa2,bf16x8 pa3){
  #pragma unroll
  for(int d0=0;d0<2;++d0){s16x4 lo[4],hi[4];
    #pragma unroll
    for(int ks=0;ks<4;++ks){
      asm volatile("ds_read_b64_tr_b16 %0,%1 offset:%c2":"=&v"(lo[ks]):"v"(vb),"i"(d0*4096+ks*1024):"memory");
      asm volatile("ds_read_b64_tr_b16 %0,%1 offset:%c2":"=&v"(hi[ks]):"v"(vb),"i"(d0*4096+ks*1024+512):"memory");}
    asm volatile("s_waitcnt lgkmcnt(0)":::"memory");SBAR();
    #define PK(k) (bf16x8){lo[k][0],lo[k][1],lo[k][2],lo[k][3],hi[k][0],hi[k][1],hi[k][2],hi[k][3]}
    o[d0]=__builtin_amdgcn_mfma_f32_32x32x16_bf16(pa0,PK(0),o[d0],0,0,0);
    o[d0]=__builtin_amdgcn_mfma_f32_32x32x16_bf16(pa1,PK(1),o[d0],0,0,0);
    o[d0]=__builtin_amdgcn_mfma_f32_32x32x16_bf16(pa2,PK(2),o[d0],0,0,0);
    o[d0]=__builtin_amdgcn_mfma_f32_32x32x16_bf16(pa3,PK(3),o[d0],0,0,0);
    #undef PK
  }
}

#ifndef ATTN_STORE16
#define ATTN_STORE16(p,v) (*(u32x4*)(p)=(v))
#endif
template<int THRL> __device__ __forceinline__ void attn_unit(int b,int h,int qb,const bf16*Q,const bf16*__restrict__ K,const bf16*__restrict__ V,bf16*O,const float*__restrict__ kmp,char*shm){
  int tid_o=threadIdx.x; asm volatile("":"+v"(tid_o));
  const int tid=tid_o,lane=tid&63,r32=lane&31,hi=lane>>5; const int wid=__builtin_amdgcn_readfirstlane(tid>>6);
  const long rowbase=(long)b*SEQ; const int q0=qb*QB;
  const bf16*Qw=Q+(rowbase+q0+wid*QBLK)*DM+h*D;
  const bf16*Kh=K+rowbase*DM+h*D,*Vh=V+rowbase*DM+h*D;
  float*kmt=(float*)(shm+LDS_KM);
  const float kmv=(kmp[((size_t)(b*8+(tid>>6)))*DM+h*D+(tid&63)]+kmp[(size_t)64*DM+((size_t)(b*8+(tid>>6)))*DM+h*D+(tid&63)])*(1.0f/256.0f);
  const float slope2=__builtin_amdgcn_exp2f(-0.5f*(float)(h+1))*1.4426950408889634f;
  const unsigned lds0=(unsigned)(uintptr_t)shm;
  float*wsf=(float*)(shm+LDS_WS)+wid*64;
  const bf16*ksrc=Kh+(long)lane*DM+wid*8;
  const bf16*vsrc=Vh+(long)(16*(wid&3)+(lane>>2))*DM+(wid>>2)*32+(lane&3)*8;
  const unsigned kdst=lds0+LDS_K+wid*1024, vdst=lds0+LDS_V+wid*1024;
  #define DMA_K(t,slot) glds16(ksrc+(long)(t)*KVBLK*DM,(unsigned)__builtin_amdgcn_readfirstlane(kdst+(slot)))
  #define DMA_V(t,slot) glds16(vsrc+(long)(t)*KVBLK*DM,(unsigned)__builtin_amdgcn_readfirstlane(vdst+(slot)))
  const int vb0=(int)(lds0+LDS_V)+((lane>>4)&1)*32+(lane&3)*8+(4*hi+((lane&15)>>2))*64;
  const char*Kbase=shm+LDS_K; bf16x8 kf[8];
  const lds_cptr shm3=(lds_cptr)shm; const lds_cptr kp0=shm3+LDS_K+hi*1024+r32*16; const lds_cptr vp0=shm3+LDS_V+((lane>>4)&1)*32+(lane&3)*8+(4*hi+((lane&15)>>2))*64;
  const int NT=(q0+QB)/KVBLK;
  DMA_K(0,0);DMA_V(0,0);DMA_K(1,SLOTB);
  bf16x8 qr[4];
  #pragma unroll
  for(int d0=0;d0<4;++d0)qr[d0]=*reinterpret_cast<const bf16x8*>(&Qw[(long)r32*DM+d0*16+hi*8]);
  float mhat=0.f,l_reg=0.f;f32x16 o[2];o[0]=f32x16{};o[1]=f32x16{};
  const int qrel=wid*QBLK+r32;
  f32x16 cb; _Pragma("unroll") for(int r=0;r<16;++r)cb[r]=slope2*(float)crow(r,hi); asm volatile("":"+v"(cb));
  float nmq=-slope2*(float)(q0+qrel);
  const float s64=slope2*64.0f, s32=slope2*32.0f; unsigned sel=0u;
  kmt[tid]=kmv;
  #define CMASK(P0,P1,t) do{int jb_=(t)-(NT-4); if(jb_>=0)cmask(P0,P1,jb_,qrel,hi);}while(0)
  #define MASKV (-30000.0f)
  #define CINIT(C0,C1,t) do{ const float mk_=((sel>>((t)>>2))&1u)?0.f:MASKV; const float b0_=nmq+s64*(float)(t)+mk_, b1_=b0_+s32; \
    _Pragma("unroll") for(int r=0;r<16;++r){C0[r]=cb[r]+b0_;C1[r]=cb[r]+b1_;} }while(0)
  bool resc=false;
  #define RESC() do{ if(resc){ asm volatile("s_waitcnt lgkmcnt(0)":::"memory"); \
      _Pragma("unroll") for(int d_=0;d_<2;++d_) _Pragma("unroll") for(int r=0;r<16;++r)o[d_][r]*=wsf[crow(r,hi)]; } }while(0)
  f32x16 pA0,pA1,pB0,pB1;
  int sl_prev=0,sl_cur=0,sl_next=SLOTB;
  #define ROT() do{sl_prev=sl_cur;sl_cur=sl_next;sl_next=(sl_next==(NSLOT-1)*SLOTB)?0:sl_next+SLOTB;}while(0)
  DMA_K(2,2*SLOTB);
  WAIT_BAR(3);
  { float gt[8];
    _Pragma("unroll") for(int n=0;n<8;++n){ float sg=0.f;
      _Pragma("unroll") for(int d0=0;d0<4;++d0){ const float*kp_=kmt+n*64+d0*16+hi*8; const f32x4_t k0_=*(const f32x4_t*)kp_, k1_=*(const f32x4_t*)(kp_+4);
        sg+=(bfu(qr[d0][0])*k0_[0]+bfu(qr[d0][1])*k0_[1])+(bfu(qr[d0][2])*k0_[2]+bfu(qr[d0][3])*k0_[3])+(bfu(qr[d0][4])*k1_[0]+bfu(qr[d0][5])*k1_[1])+(bfu(qr[d0][6])*k1_[2]+bfu(qr[d0][7])*k1_[3]); }
      { auto rr=__builtin_amdgcn_permlane32_swap(__float_as_uint(sg),__float_as_uint(sg),false,false); sg=__uint_as_float(rr[0])+__uint_as_float(rr[1]); }
      gt[n]=(n<qb)?sg:-3.0e38f; }
    const int nsel=qb<3?qb:3;
    for(int r_=0;r_<nsel;++r_){ float best=-3.0e38f; int bi=0;
      _Pragma("unroll") for(int n=0;n<8;++n){ const bool ok=(n<qb)&&!((sel>>n)&1u)&&(gt[n]>best); if(ok){best=gt[n];bi=n;} }
      sel|=1u<<bi; }
    sel|=1u<<qb; }
  CINIT(pA0,pA1,0);
  qkt(pA0,pA1,Kbase,qr,pA0,pA1,r32,hi);asm volatile("s_nop 15\n\ts_nop 7":"+v"(pA0),"+v"(pA1));CMASK(pA0,pA1,0);
  { const float rm=rowmax(pA0,pA1);
    if(__any(rm>(float)THRL)){ const float dl=__builtin_fmaxf(rm,0.f); mhat+=dl; nmq-=dl;
      _Pragma("unroll") for(int r=0;r<16;++r){pA0[r]-=dl;pA1[r]-=dl;} } }
  _Pragma("unroll") for(int r=0;r<16;++r)pA0[r]=__builtin_amdgcn_exp2f(pA0[r]);
  _Pragma("unroll") for(int r=0;r<16;++r)pA1[r]=__builtin_amdgcn_exp2f(pA1[r]);
  WAIT_BAR(0);
  DMA_K(3,0);DMA_V(1,SLOTB);
  ROT();
  kload8(kf,kp0+sl_cur);
  WAIT_BAR(2);
  s16x4 vlo[8],vhi[8]; u32x4 pw0,pw1,pw2,pw3;
  #define PKW(P,B) cvtpk_s(P[B],P[B+1])
  #define PAF(k) __builtin_bit_cast(bf16x8,pw##k)
  #define VFR(i) (bf16x8){vlo[i][0],vlo[i][1],vlo[i][2],vlo[i][3],vhi[i][0],vhi[i][1],vhi[i][2],vhi[i][3]}
  #define PIN(x) asm volatile("":"+v"(x))
  #define MX3(a,b,c) __builtin_fmaxf(__builtin_fmaxf((a),(b)),(c))
  #define GAPA(MF,A0,A1,A2,A3,W0,W1,PW) do{ MF; sacc+=A0; sacc+=A1; sacc+=A2; sacc+=A3; PIN(sacc); W0; W1; PIN(PW); SBAR(); }while(0)
  #define EX(v) __builtin_amdgcn_exp2f(v)
  #define GAPB(MF,X,B) do{ MF; X[B]=EX(X[B]); X[B+1]=EX(X[B+1]); X[B+2]=EX(X[B+2]); X[B+3]=EX(X[B+3]); PIN(X); SBAR(); }while(0)
  #define VRD(i) do{ vlo[i]=vtr(vp_+(((i)>>2)*4096+((i)&3)*1024)); vhi[i]=vtr(vp_+(((i)>>2)*4096+((i)&3)*1024+512)); }while(0)
  #define KRD(G,j) do{ if(G){ kload2(kf,kp0+sl_next,j); SBAR(); } }while(0)
  #define STEP(C0,C1,P0,P1,t,GK,GV,GL) do{ SBAR(); \
    CINIT(C0,C1,t); SBAR(); \
    const lds_cptr vp_=vp0+sl_prev; \
    VRD(0); SBAR(); float sacc=(P0[0]+P0[1]); \
    GAPA(C0=__builtin_amdgcn_mfma_f32_32x32x16_bf16(kf[0],qr[0],C0,0,0,0), P0[2],P0[3],P0[4],P0[5],     pw0[0]=PKW(P0,0), pw0[1]=PKW(P0,2), pw0); \
    VRD(4); SBAR(); GAPA(C1=__builtin_amdgcn_mfma_f32_32x32x16_bf16(kf[1],qr[0],C1,0,0,0), P0[6],P0[7],P0[8],P0[9],     pw0[2]=PKW(P0,4), pw0[3]=PKW(P0,6), pw0); \
    VRD(1); SBAR(); GAPA(C0=__builtin_amdgcn_mfma_f32_32x32x16_bf16(kf[2],qr[1],C0,0,0,0),   P0[10],P0[11],P0[12],P0[13], pw1[0]=PKW(P0,8), pw1[1]=PKW(P0,10), pw1); \
    VRD(5); SBAR(); GAPA(C1=__builtin_amdgcn_mfma_f32_32x32x16_bf16(kf[3],qr[1],C1,0,0,0),   P0[14],P0[15],P1[0],P1[1],   pw1[2]=PKW(P0,12),pw1[3]=PKW(P0,14), pw1); \
    VRD(2); SBAR(); GAPA(C0=__builtin_amdgcn_mfma_f32_32x32x16_bf16(kf[4],qr[2],C0,0,0,0),   P1[2],P1[3],P1[4],P1[5],     pw2[0]=PKW(P1,0), pw2[1]=PKW(P1,2), pw2); \
    VRD(6); SBAR(); GAPA(C1=__builtin_amdgcn_mfma_f32_32x32x16_bf16(kf[5],qr[2],C1,0,0,0),   P1[6],P1[7],P1[8],P1[9],     pw2[2]=PKW(P1,4), pw2[3]=PKW(P1,6), pw2); \
    VRD(3); SBAR(); GAPA(C0=__builtin_amdgcn_mfma_f32_32x32x16_bf16(kf[6],qr[3],C0,0,0,0),   P1[10],P1[11],P1[12],P1[13], pw3[0]=PKW(P1,8), pw3[1]=PKW(P1,10), pw3); \
    VRD(7); SBAR(); GAPA(C1=__builtin_amdgcn_mfma_f32_32x32x16_bf16(kf[7],qr[3],C1,0,0,0),   P1[14],P1[15],0.f,0.f,       pw3[2]=PKW(P1,12),pw3[3]=PKW(P1,14), pw3); \
    l_reg+=sacc; \
    if(GK){DMA_K((t)+3,sl_cur);} if(GV){DMA_V((t)+1,sl_next);} \
    CMASK(C0,C1,t); \
    { float a=MX3(C0[0],C0[1],C1[0]),b=MX3(C0[2],C0[3],C1[1]); a=MX3(a,C1[2],C1[3]); \
      _Pragma("unroll") for(int r=4;r<16;r+=4){a=MX3(a,C0[r],C0[r+1]);b=MX3(b,C0[r+2],C0[r+3]);a=MX3(a,C1[r],C1[r+1]);b=MX3(b,C1[r+2],C1[r+3]);} \
      float rm=__builtin_fmaxf(a,b); { auto rr=__builtin_amdgcn_permlane32_swap(__float_as_uint(rm),__float_as_uint(rm),false,false); rm=__builtin_fmaxf(__uint_as_float(rr[0]),__uint_as_float(rr[1])); } \
      resc=false; \
      if(__builtin_expect(__any(rm>(float)THRL),0)){ const float dl=__builtin_fmaxf(rm,0.f); mhat+=dl; \
        _Pragma("unroll") for(int r=0;r<16;++r){C0[r]-=dl;C1[r]-=dl;} \
        nmq-=dl; \
        const float f=__builtin_amdgcn_exp2f(-dl); l_reg*=f; if(hi==0)wsf[r32]=f; resc=true; } } \
    SBAR(); \
    GAPB(o[0]=__builtin_amdgcn_mfma_f32_32x32x16_bf16(PAF(0),VFR(0),o[0],0,0,0), C0,0); \
    GAPB(o[1]=__builtin_amdgcn_mfma_f32_32x32x16_bf16(PAF(0),VFR(4),o[1],0,0,0), C0,4); \
    KRD(GL,0); GAPB(o[0]=__builtin_amdgcn_mfma_f32_32x32x16_bf16(PAF(1),VFR(1),o[0],0,0,0), C0,8); \
    KRD(GL,1); GAPB(o[1]=__builtin_amdgcn_mfma_f32_32x32x16_bf16(PAF(1),VFR(5),o[1],0,0,0), C0,12); \
    KRD(GL,2); GAPB(o[0]=__builtin_amdgcn_mfma_f32_32x32x16_bf16(PAF(2),VFR(2),o[0],0,0,0), C1,0); \
    KRD(GL,3); GAPB(o[1]=__builtin_amdgcn_mfma_f32_32x32x16_bf16(PAF(2),VFR(6),o[1],0,0,0), C1,4); \
    GAPB(o[0]=__builtin_amdgcn_mfma_f32_32x32x16_bf16(PAF(3),VFR(3),o[0],0,0,0), C1,8); \
    GAPB(o[1]=__builtin_amdgcn_mfma_f32_32x32x16_bf16(PAF(3),VFR(7),o[1],0,0,0), C1,12); \
    }while(0)
  int t=1;
  #undef CMASK
  #define CMASK(P0,P1,t) do{}while(0)
  for(;t+5<NT;t+=2){
    STEP(pB0,pB1,pA0,pA1,t,true,true,true);     WAIT_BAR(2); RESC(); ROT();
    STEP(pA0,pA1,pB0,pB1,t+1,true,true,true);   WAIT_BAR(2); RESC(); ROT();
  }
  #undef CMASK
  #define CMASK(P0,P1,t) do{int jb_=(t)-(NT-4); if(jb_>=0)cmask(P0,P1,jb_,qrel,hi);}while(0)
  #define ENDW(tt) do{ if((tt)+3<NT){WAIT_BAR(2);} else if((tt)+2<NT){WAIT_BAR(1);} else {WAIT_BAR(0);} }while(0)
  for(;t+1<NT;t+=2){
    STEP(pB0,pB1,pA0,pA1,t,(t+3<NT),(t+1<NT),(t+1<NT));       ENDW(t);   RESC(); ROT();
    STEP(pA0,pA1,pB0,pB1,t+1,(t+4<NT),(t+2<NT),(t+2<NT));     ENDW(t+1); RESC(); ROT();
  }
  STEP(pB0,pB1,pA0,pA1,NT-1,false,false,false); RESC();
  { float sacc=pB0[0]+pB0[1]; _Pragma("unroll") for(int r=2;r<16;++r)sacc+=pB0[r]; _Pragma("unroll") for(int r=0;r<16;++r)sacc+=pB1[r]; l_reg+=sacc;
    pw0=(u32x4){PKW(pB0,0),PKW(pB0,2),PKW(pB0,4),PKW(pB0,6)};pw1=(u32x4){PKW(pB0,8),PKW(pB0,10),PKW(pB0,12),PKW(pB0,14)};pw2=(u32x4){PKW(pB1,0),PKW(pB1,2),PKW(pB1,4),PKW(pB1,6)};pw3=(u32x4){PKW(pB1,8),PKW(pB1,10),PKW(pB1,12),PKW(pB1,14)};
    SBAR(); pv(o,vb0+sl_cur,PAF(0),PAF(1),PAF(2),PAF(3)); }
  #undef PKW
  #undef PAF
  #undef VFR
  #undef PIN
  #undef MX3
  #undef GAPA
  #undef GAPB
  #undef EX
  #undef VRD
  #undef KRD
  #undef STEP
  #undef ENDW
  {auto rr=__builtin_amdgcn_permlane32_swap(__float_as_uint(l_reg),__float_as_uint(l_reg),false,false);l_reg=__uint_as_float(rr[0])+__uint_as_float(rr[1]);}
  if(hi==0)wsf[32+r32]=l_reg;asm volatile("s_waitcnt lgkmcnt(0)":::"memory");
  float rli[16];
  #pragma unroll
  for(int r=0;r<16;++r)rli[r]=__builtin_amdgcn_rcpf(wsf[32+crow(r,hi)]);
  bf16*Ow=O+(rowbase+q0+wid*QBLK)*DM+h*D;
  { bf16*stg=(bf16*)(shm+LDS_OST)+wid*2048;
    #pragma unroll
    for(int r=0;r<16;++r){const int orow=crow(r,hi);
      #pragma unroll
      for(int d0=0;d0<2;++d0)stg[orow*64+d0*32+r32]=__float2bfloat16(o[d0][r]*rli[r]);}
    asm volatile("s_waitcnt lgkmcnt(0)":::"memory");
    #pragma unroll
    for(int i=0;i<4;++i){const int row=i*8+(lane>>3),ch=lane&7; const u32x4 v=*(const u32x4*)(stg+row*64+ch*8); ATTN_STORE16(Ow+(long)row*DM+ch*8,v);} }
  asm volatile("s_waitcnt lgkmcnt(0)\n\ts_barrier":::"memory");
  #undef DMA_K
  #undef DMA_V
  #undef CMASK
  #undef CINIT
  #undef MASKV
  #undef RESC
  #undef ROT
}
constexpr int ATTN_LDS_BYTES=LDS_BYTES;
struct AttnTensors { const bf16* Q; const bf16* K; const bf16* V; bf16* O; const float* kmp; };
template<int THRL=8> __device__ __forceinline__ void attn_phase(char*lds,const AttnTensors&T,int G,int c0){
  for(int u=c0;u<BATCH*NHEAD*NQB;u+=G){
    const int kq=u>>8,c=u&255,bh=((c>>4)<<3)|(c&7),sub=(c>>3)&1;
    const int qb=sub?((kq==0)?2:(kq==1)?5:(kq==2)?3:4):((kq==0)?0:(kq==1)?7:(kq==2)?1:6);
    attn_unit<THRL>(bh/NHEAD,bh%NHEAD,qb,T.Q,T.K,T.V,T.O,T.kmp,lds); }
}
#undef SBAR
#undef WAIT_BAR
}

constexpr unsigned DUP_MASK = 0u; constexpr int S5_PROBE_VAR = 0;
#ifndef MK_ONE_LAUNCH
#define MK_ONE_LAUNCH 1
#endif
__global__ void __launch_bounds__(NTHR, 2) mk_fwd(Args a) {
    extern __shared__ __attribute__((aligned(16))) unsigned char lds_raw[];
    LAS unsigned char* lds = (LAS unsigned char*)lds_raw;
    volatile LAS unsigned* MISC = (volatile LAS unsigned*)(lds + MISC_OFF);
    const int tid = threadIdx.x, lane = tid & 63, wave = __builtin_amdgcn_readfirstlane(tid >> 6);
    const int G = gridDim.x; const int bx = blockIdx.x; const int vcu = (G % 8 == 0) ? (bx % 8) * (G / 8) + bx / 8 : bx;
    gu32* ctl = (gu32*)(a.ws + WS_CTL);
    for (int u = tid; u < (LDS_BYTES - LDSCTL_OFF) / 4; u += NTHR) ((LAS unsigned*)(lds + LDSCTL_OFF))[u] = 0u;
    __syncthreads();
    const int lo = a.ph_lo, hi = a.ph_hi; const bool multi = (hi - lo) > 1;
    XcdBarrier bar; bar.bar = (unsigned*)(ctl + CW_BAR); bar.x = 0; bar.st = nullptr;
    if (multi) bar = xcd_barrier_post((unsigned*)(ctl + CW_BAR), MISC + 8);
    int pid = 0;
#define IN_PH() (lo <= pid && pid < hi)
#define PH_REP(kb) for (int rep_ = 0; rep_ < 1 + (int)((DUP_MASK >> (kb)) & 1u); ++rep_)
#define END_PH() do { if (IN_PH() && pid + 1 < hi) xcd_barrier(bar); ++pid; } while (0)
    if (IN_PH()) PH_REP(0) phase_prologue(a, lds, vcu, G);
    END_PH();
    int sidx = 0;
#pragma nounroll
    for (int l = 0; l < DEPTH; ++l) {
#pragma nounroll
        for (int sub = 0; sub < 3; ++sub) {
            if (sub != 1) {
                const int f = sub >> 1, j = 2 * l + f;
                if (IN_PH()) PH_REP(1) { unsigned char* ws = opq(a.ws); pg8::stat_t* stats = (pg8::stat_t*)(ws + WS_STATS); bf16* hb = (bf16*)(ws + WS_HB); bf16* act = (bf16*)(ws + WS_ACT); (void)stats; (void)hb; (void)act; pg8::Gemm g{hb, (const bf16*)(ws + WS_WIN + (size_t)j * WIN_BYTES), M, 2 * DFF, DM}; pg8::StaticOrder S; S.init(M, 2 * DFF, G, bx);
                    pg8::EpiSwiGLU E{act, DFF, stats + (size_t)sidx * M};
                    pg8::gemm_phase<pg8::EpiSwiGLU, pg8::StaticOrder, true, true>(lds + RING_OFF, g, S, E);
                    if (G == 256 && bx >= 128 && rep_ == 0) convert_tail_slot(a, lds, j, (bx - 128) * NWAVES + __builtin_amdgcn_readfirstlane(threadIdx.x >> 6), 128 * NWAVES); }
                END_PH();
                if (IN_PH()) { unsigned char* ws = opq(a.ws); pg8::stat_t* stats = (pg8::stat_t*)(ws + WS_STATS); bf16* hb = (bf16*)(ws + WS_HB); bf16* act = (bf16*)(ws + WS_ACT); (void)stats; (void)hb; (void)act; pg8::Gemm g{act, (const bf16*)(ws + WS_WOUT + (size_t)j * WOUT_BYTES), M, DM, DFF}; pg8::StaticOrder S; S.init(M, DM, G, bx);
                    pg8::EpiRes E{hb, stats + (size_t)(sidx + 1) * M, 0.5f};
                    pg8::gemm_phase<pg8::EpiRes, pg8::StaticOrder, true, true>(lds + RING_OFF, g, S, E); }
                END_PH(); ++sidx;
            } else if (l < NA) {
                if (IN_PH()) PH_REP(2) { if (((DUP_MASK >> 2) & 1u) && rep_ == 0) s5::phase_s5<S5_PROBE_VAR>(a, lds + RING_OFF, l, (const pg8::stat_t*)(opq(a.ws) + WS_STATS) + (size_t)sidx * M, G); else s5::phase_s5<0>(a, lds + RING_OFF, l, (const pg8::stat_t*)(opq(a.ws) + WS_STATS) + (size_t)sidx * M, G); }
                END_PH();
                if (IN_PH()) { unsigned char* ws = opq(a.ws); pg8::stat_t* stats = (pg8::stat_t*)(ws + WS_STATS); bf16* hb = (bf16*)(ws + WS_HB); bf16* act = (bf16*)(ws + WS_ACT); (void)stats; (void)hb; (void)act; pg8::Gemm g{act, (const bf16*)(ws + WS_WGLU + (size_t)l * WGLU_BYTES), M, 2 * DM, DM}; pg8::StaticOrder S; S.init(M, 2 * DM, G, bx);
                    pg8::EpiGluRes E{hb, stats + (size_t)(sidx + 1) * M};
                    pg8::gemm_phase<pg8::EpiGluRes, pg8::StaticOrder, true, true>(lds + RING_OFF, g, S, E); }
                END_PH(); ++sidx;
            } else {
                const int jb = l - NA;
                if (IN_PH()) PH_REP(4) { unsigned char* ws = opq(a.ws); pg8::stat_t* stats = (pg8::stat_t*)(ws + WS_STATS); bf16* hb = (bf16*)(ws + WS_HB); bf16* act = (bf16*)(ws + WS_ACT); (void)stats; (void)hb; (void)act; pg8::Gemm g{hb, (const bf16*)(ws + WS_WQ + (size_t)jb * 2 * MiB), M, DM, DM}; pg8::StaticOrder S; S.init(M, DM, G, bx);
                    pg8::EpiRowScale<false> E{act, act, stats + (size_t)sidx * M, C2, nullptr};
                    pg8::gemm_phase<pg8::EpiRowScale<false>, pg8::StaticOrder, true, true>(lds + RING_OFF, g, S, E); }
                END_PH();
                if (IN_PH()) PH_REP(5) { unsigned char* ws = opq(a.ws);
                    const attn_body::AttnTensors AT{(const attn_body::bf16*)(ws + WS_ACT), (const attn_body::bf16*)(ws + WS_K), (const attn_body::bf16*)(ws + WS_V), (attn_body::bf16*)(ws + WS_ACT + 32 * MiB), (const float*)(ws + WS_KMP)};
                    attn_body::attn_phase<8>((char*)lds_raw + RING_OFF, AT, G, bx); }
                END_PH();
                if (IN_PH()) { unsigned char* ws = opq(a.ws); pg8::stat_t* stats = (pg8::stat_t*)(ws + WS_STATS); bf16* hb = (bf16*)(ws + WS_HB); bf16* act = (bf16*)(ws + WS_ACT); (void)stats; (void)hb; (void)act; pg8::Gemm g{(const bf16*)(ws + WS_ACT + 32 * MiB), (const bf16*)(ws + WS_WO + (size_t)jb * 2 * MiB), M, DM, DM}; pg8::StaticOrder S; S.init(M, DM, G, bx);
                    pg8::EpiRes E{hb, stats + (size_t)(sidx + 1) * M, 1.0f};
                    pg8::gemm_phase<pg8::EpiRes, pg8::StaticOrder, true, true>(lds + RING_OFF, g, S, E); }
                END_PH(); ++sidx;
            }
            if (l == NA - 1 && sub == 2) {
                if (IN_PH()) PH_REP(3) { unsigned char* ws = opq(a.ws); pg8::stat_t* stats = (pg8::stat_t*)(ws + WS_STATS); bf16* hb = (bf16*)(ws + WS_HB); bf16* act = (bf16*)(ws + WS_ACT); (void)stats; (void)hb; (void)act; pg8::Gemm g{hb, (const bf16*)(ws + WS_WKV), M, 2 * DM, DM}; pg8::StaticOrder S; S.init(M, 2 * DM, G, bx);
                    pg8::EpiRowScale<true> E{(bf16*)(ws + WS_K), (bf16*)(ws + WS_V), stats + (size_t)sidx * M, 1.0f, (float*)(ws + WS_KMP)};
                    pg8::gemm_phase<pg8::EpiRowScale<true>, pg8::StaticOrder, true, true>(lds + RING_OFF, g, S, E); }
            }
        }
    }
    if (IN_PH()) phase_final(a, vcu, G);
    ++pid;
#undef IN_PH
#undef END_PH
}

extern "C" void kernel_launch(void* const* d_in, const int* in_sizes, int n_in, void* d_out, int out_size, void* d_ws, size_t ws_size, hipStream_t stream) {
    static int grid = 0;
    if (grid == 0) {
        if (n_in != 22 || in_sizes[0] != M * DM || out_size != M * DM || ws_size < WS_END) { fprintf(stderr, "kernel_launch: unexpected shapes / workspace (n_in %d, ws %zu < %zu); nothing launched\n", n_in, ws_size, (size_t)WS_END); grid = -1; return; }
        int dev = 0, cus = 0, per_cu = 0;
        if (hipGetDevice(&dev) != hipSuccess || hipDeviceGetAttribute(&cus, hipDeviceAttributeMultiprocessorCount, dev) != hipSuccess) { grid = -1; return; }
        if (hipFuncSetAttribute((const void*)mk_fwd, hipFuncAttributeMaxDynamicSharedMemorySize, LDS_BYTES) != hipSuccess) { fprintf(stderr, "kernel_launch: hipFuncSetAttribute failed\n"); grid = -1; return; }
        if (hipOccupancyMaxActiveBlocksPerMultiprocessor(&per_cu, (const void*)mk_fwd, NTHR, LDS_BYTES) != hipSuccess || per_cu < 1) fprintf(stderr, "kernel_launch: occupancy query reports %d\n", per_cu);
        (void)hipGetLastError();
        grid = cus;
    }
    if (grid < 0) return;
    if (hipMemsetAsync((char*)d_ws + WS_CTL, 0, CTL_ZERO_BYTES, stream) != hipSuccess) return;
    Args a{};
    for (int i = 0; i < 22; ++i) a.in[i] = (const float*)d_in[i];
    a.out = (float*)d_out; a.ws = (unsigned char*)d_ws;
#if MK_ONE_LAUNCH
    a.ph_lo = 0; a.ph_hi = NPHASE;
    hipLaunchKernelGGL(mk_fwd, dim3(grid), dim3(NTHR), LDS_BYTES, stream, a);
#else
    for (int p = 0; p < NPHASE; ++p) { a.ph_lo = p; a.ph_hi = p + 1; hipLaunchKernelGGL(mk_fwd, dim3(grid), dim3(NTHR), LDS_BYTES, stream, a); }
#endif
}
```
